# Optimizing an MI355X kernel written in HIP

```python
import math
import jax
import jax.numpy as jnp
from jax import lax
import numpy as np

D_MODEL = 2048
BATCH = 2
SEQ = 4096
DEPTH = 4
DEC_BATCH = 8
DEC_SEQ = 4
PAST_LEN = 16384
PAGE_SIZE = 128

N_BRANCH = 4
BR_W = D_MODEL // N_BRANCH
A_GROUPS = 4
A_GW = BR_W // A_GROUPS
CHUNK = 128
B_HEADS = 4
B_HD = BR_W // B_HEADS
B_PATTERNS = ((128, 1), (512, 4), (2048, 16))
B_GROUPS = len(B_PATTERNS)
N_BUCKETS = 32
MAX_DIST = 2048
C_WINDOWS = (2, 4, 8, 16)
C_GROUPS = len(C_WINDOWS)
C_GW = BR_W // C_GROUPS
POOL_HIST = max(C_WINDOWS) - 1
CONV_W = 3
D_FF = -(-8 * D_MODEL // (3 * 256)) * 256
N_IN = 2 * BR_W + B_GROUPS * 3 * BR_W + BR_W + 3 * BR_W
EPS = 1e-6
NEG = -1e30

kernel_name = "hybrid_gated_branch_decoder_step"


def rmsnorm(x, g):
    xf = x.astype(jnp.float32)
    y = xf * lax.rsqrt(jnp.mean(xf * xf, axis=-1, keepdims=True) + EPS)
    return (y * g).astype(x.dtype)


def layernorm(x, g, b):
    xf = x.astype(jnp.float32)
    mu = jnp.mean(xf, axis=-1, keepdims=True)
    var = jnp.mean(jnp.square(xf - mu), axis=-1, keepdims=True)
    return ((xf - mu) * lax.rsqrt(var + 1e-5) * g + b).astype(x.dtype)


def t5_bucket(dist):
    max_exact = N_BUCKETS // 2
    n = jnp.maximum(dist, 0)
    nf = jnp.maximum(n, 1).astype(jnp.float32)
    large = max_exact + (jnp.log(nf / max_exact) / math.log(MAX_DIST / max_exact)
                         * (N_BUCKETS - max_exact)).astype(jnp.int32)
    large = jnp.minimum(large, N_BUCKETS - 1)
    return jnp.where(n < max_exact, n, large)


def chunk_gmlp(pa, ln_g, ln_b, ws, bs):
    z = jax.nn.gelu(pa)
    u, v = jnp.split(z, 2, axis=-1)
    v = layernorm(v, ln_g, ln_b)
    b, t, _ = v.shape
    nc = -(-t // CHUNK)
    vp = jnp.pad(v, ((0, 0), (0, nc * CHUNK - t), (0, 0))).reshape(b, nc, CHUNK, A_GROUPS, A_GW)
    tri = jnp.tril(jnp.ones((CHUNK, CHUNK), dtype=bool))
    wm = jnp.where(tri[None], ws, jnp.zeros((), ws.dtype))
    mix = jnp.einsum('gij,bnjgc->bnigc', wm, vp) + bs.T[None, None, :, :, None]
    mix = mix.reshape(b, nc * CHUNK, BR_W)[:, :t]
    return u * mix, v


def dilated_window_prompt(q, k, v, tab, window, dil):
    b, s, h, e = q.shape
    nk = window // dil
    L = s // dil
    nb = -(-L // nk)
    Lp = nb * nk

    def to_sub(a):
        a = a.reshape(b, L, dil, h, e).transpose(0, 2, 1, 3, 4)
        return jnp.pad(a, ((0, 0), (0, 0), (0, Lp - L), (0, 0), (0, 0)))

    def band(a):
        a = jnp.pad(a, ((0, 0), (0, 0), (nk, 0), (0, 0), (0, 0))).reshape(b, dil, nb + 1, nk, h, e)
        return jnp.concatenate([a[:, :, :-1], a[:, :, 1:]], axis=3)

    qb = to_sub(q).reshape(b, dil, nb, nk, h, e).astype(jnp.float32)
    kb = band(to_sub(k)).astype(jnp.float32)
    vb = band(to_sub(v)).astype(jnp.float32)
    i = jnp.arange(nk)[:, None]
    j = jnp.arange(2 * nk)[None, :]
    diff = nk + i - j
    valid = (diff >= 0) & (diff <= nk)
    blk = jnp.arange(nb)[:, None, None]
    mask = valid[None] & ((blk > 0) | (j >= nk)[None])
    bias = tab[t5_bucket(diff * dil)].transpose(2, 0, 1)
    logits = jnp.einsum('brnihe,brnjhe->brnhij', qb, kb) * (e ** -0.5) + bias.astype(jnp.float32)
    logits = jnp.where(mask[None, None, :, None], logits, NEG)
    lse = jax.nn.logsumexp(logits, axis=-1)
    p = jnp.exp(logits - lse[..., None])
    o = jnp.einsum('brnhij,brnjhe->brnihe', p, vb)
    o = o.reshape(b, dil, Lp, h, e)[:, :, :L].transpose(0, 2, 1, 3, 4).reshape(b, s, h, e)
    lse = lse.transpose(0, 1, 2, 4, 3).reshape(b, dil, Lp, h)[:, :, :L].transpose(0, 2, 1, 3).reshape(b, s, h)
    return o, lse


def dilated_window_sample(q, k_new, v_new, kv_buf, tab, window, dil):
    b, t, h, e = q.shape
    wb = kv_buf.shape[1]
    nk = window // dil
    kc = jnp.concatenate([kv_buf[:, :, 0], k_new], axis=1)
    vc = jnp.concatenate([kv_buf[:, :, 1], v_new], axis=1)
    steps = jnp.arange(nk + 1)
    idx = wb + jnp.arange(t)[:, None] - steps[None, :] * dil
    valid = idx >= 0
    idx = jnp.maximum(idx, 0)
    kg = kc[:, idx].astype(jnp.float32)
    vg = vc[:, idx].astype(jnp.float32)
    bias = tab[t5_bucket(steps * dil)].T.astype(jnp.float32)
    logits = jnp.einsum('bthe,btjhe->bthj', q.astype(jnp.float32), kg) * (e ** -0.5) + bias[None, None]
    logits = jnp.where(valid[None, :, None, :], logits, NEG)
    lse = jax.nn.logsumexp(logits, axis=-1)
    p = jnp.exp(logits - lse[..., None])
    o = jnp.einsum('bthj,btjhe->bthe', p, vg)
    return o, lse


def combine_dilations(outs, lses):
    w = jax.nn.softmax(jnp.stack(lses, axis=0), axis=0)
    return jnp.einsum('gbth,gbthe->bthe', w, jnp.stack(outs, axis=0))


def multiscale_pool(pc, hist, start, pool_w, pool_b, pool_scale):
    b, t, _ = pc.shape
    full = jnp.concatenate([hist, pc], axis=1).astype(jnp.float32)
    cs = jnp.concatenate([jnp.zeros((b, 1, BR_W), jnp.float32), jnp.cumsum(full, axis=1)], axis=1)
    end = POOL_HIST + 1 + jnp.arange(t)
    pos = start + jnp.arange(t)
    means = []
    for gi, win in enumerate(C_WINDOWS):
        sl = slice(gi * C_GW, (gi + 1) * C_GW)
        cnt = jnp.minimum(pos + 1, win).astype(jnp.float32)
        means.append((cs[:, end, sl] - cs[:, end - win, sl]) / cnt[None, :, None])
    pooled = (jnp.concatenate(means, axis=-1) - full[:, POOL_HIST:]).reshape(b, t, C_GROUPS, C_GW)
    y = jnp.einsum('btgc,gcd->btgd', pooled, pool_w.astype(jnp.float32)).reshape(b, t, BR_W) + pool_b
    return (y * pool_scale).astype(pc.dtype)


def short_conv(pd, hist, conv_w):
    bg, cg, hs = jnp.split(pd, 3, axis=-1)
    z = cg * hs
    zc = jnp.concatenate([hist, z], axis=1)
    t = z.shape[1]
    y = sum(zc[:, i:i + t] * conv_w[:, i] for i in range(CONV_W))
    return bg * y, z


def run_trunk(x, c, caches, params, start):
    (ln1_g, ln2_g, w_ada, b_ada, w_in, w_gate, b_gate, a_ln_g, a_ln_b, a_ws, a_bs,
     rel_bias, pool_w, pool_b, pool_scale, conv_w, w_branch, w_out, w1, w3, w2, final_g) = params
    bsz, t, _ = x.shape
    fresh = caches is None
    kv_new = [[] for _ in B_PATTERNS]
    pool_new, conv_new, chunk_new = [], [], []
    split_at = (2 * BR_W, 2 * BR_W + 3 * B_GROUPS * BR_W, 3 * BR_W + 3 * B_GROUPS * BR_W)
    for l in range(DEPTH):
        mod = jax.nn.silu(c) @ w_ada[l] + b_ada[l]
        sh1, sc1, g1, sh2, sc2, g2 = jnp.split(mod[:, None, :], 6, axis=-1)
        hn = rmsnorm(x, ln1_g[l]) * (1 + sc1) + sh1
        pa, pb, pc, pd = jnp.split(hn @ w_in[l], split_at, axis=-1)
        ya, va = chunk_gmlp(pa, a_ln_g[l], a_ln_b[l], a_ws[l], a_bs[l])
        qkv = pb.reshape(bsz, t, B_GROUPS, 3, B_HEADS, B_HD)
        outs, lses = [], []
        for gi, (win, dil) in enumerate(B_PATTERNS):
            q, k, v = qkv[:, :, gi, 0], qkv[:, :, gi, 1], qkv[:, :, gi, 2]
            tab = rel_bias[:, gi * B_HEADS:(gi + 1) * B_HEADS]
            if fresh:
                o, lse = dilated_window_prompt(q, k, v, tab, win, dil)
                keep = min(win, t)
                kv_new[gi].append(jnp.stack([k[:, t - keep:], v[:, t - keep:]], axis=2))
            else:
                o, lse = dilated_window_sample(q, k, v, caches[gi][l], tab, win, dil)
                kv_new[gi].append(jnp.stack([k, v], axis=2))
            outs.append(o)
            lses.append(lse)
        yb = combine_dilations(outs, lses).reshape(bsz, t, BR_W).astype(x.dtype)
        hist_c = jnp.zeros((bsz, POOL_HIST, BR_W), pc.dtype) if fresh else caches[3][l]
        yc = multiscale_pool(pc, hist_c, start, pool_w[l], pool_b[l], pool_scale[l])
        pool_new.append(pc[:, t - POOL_HIST:] if fresh else pc)
        hist_d = jnp.zeros((bsz, CONV_W - 1, BR_W), pd.dtype) if fresh else caches[4][l]
        yd, zd = short_conv(pd, hist_d, conv_w[l])
        conv_new.append(zd[:, t - (CONV_W - 1):] if fresh else zd)
        if not fresh:
            chunk_new.append(va)
        ys = jnp.stack([ya, yb, yc, yd], axis=2)
        br = jnp.einsum('btgc,gcd->btgd', ys, w_branch[l])
        gates = jax.nn.sigmoid(hn @ w_gate[l] + b_gate[l]).reshape(bsz, t, N_BRANCH, D_MODEL)
        x = x + g1 * (jnp.sum(gates * br, axis=2) @ w_out[l])
        hn2 = rmsnorm(x, ln2_g[l]) * (1 + sc2) + sh2
        x = x + g2 * ((jax.nn.silu(hn2 @ w1[l]) * (hn2 @ w3[l])) @ w2[l])
    y = rmsnorm(x, final_g)
    states = [jnp.stack(s, axis=0) for s in kv_new] + [jnp.stack(pool_new, axis=0), jnp.stack(conv_new, axis=0)]
    if not fresh:
        states.append(jnp.stack(chunk_new, axis=0))
    return y, states


def setup_inputs(seed: int = 0) -> dict:
    key = jax.random.key(seed)
    ks = iter(jax.random.split(key, 48))

    def nrm(shape, scale):
        return jax.random.normal(next(ks), shape, jnp.float32) * scale

    wb = [min(w, PAST_LEN) for w, _ in B_PATTERNS]
    return {
        "x_prompt": nrm((BATCH, SEQ, D_MODEL), 1.0),
        "x_sample": nrm((DEC_BATCH, DEC_SEQ, D_MODEL), 1.0),
        "c_prompt": nrm((BATCH, D_MODEL), 1.0),
        "c_sample": nrm((DEC_BATCH, D_MODEL), 1.0),
        "cache_b1": nrm((DEPTH, DEC_BATCH, wb[0], 2, B_HEADS, B_HD), 1.0),
        "cache_b2": nrm((DEPTH, DEC_BATCH, wb[1], 2, B_HEADS, B_HD), 1.0),
        "cache_b3": nrm((DEPTH, DEC_BATCH, wb[2], 2, B_HEADS, B_HD), 1.0),
        "cache_pool": nrm((DEPTH, DEC_BATCH, POOL_HIST, BR_W), 1.0),
        "cache_conv": nrm((DEPTH, DEC_BATCH, CONV_W - 1, BR_W), 0.5),
        "ln1_g": 1.0 + nrm((DEPTH, D_MODEL), 0.1),
        "ln2_g": 1.0 + nrm((DEPTH, D_MODEL), 0.1),
        "w_ada": nrm((DEPTH, D_MODEL, 6 * D_MODEL), 0.5 * D_MODEL ** -0.5),
        "b_ada": nrm((DEPTH, 6 * D_MODEL), 0.01),
        "w_in": nrm((DEPTH, D_MODEL, N_IN), D_MODEL ** -0.5),
        "w_gate": nrm((DEPTH, D_MODEL, N_BRANCH * D_MODEL), D_MODEL ** -0.5),
        "b_gate": nrm((DEPTH, N_BRANCH * D_MODEL), 0.01),
        "a_ln_g": 1.0 + nrm((DEPTH, BR_W), 0.1),
        "a_ln_b": nrm((DEPTH, BR_W), 0.01),
        "a_ws": nrm((DEPTH, A_GROUPS, CHUNK, CHUNK), CHUNK ** -0.5),
        "a_bs": 1.0 + nrm((DEPTH, A_GROUPS, CHUNK), 0.1),
        "rel_bias": nrm((N_BUCKETS, B_GROUPS * B_HEADS), 0.5),
        "pool_w": nrm((DEPTH, C_GROUPS, C_GW, C_GW), C_GW ** -0.5),
        "pool_b": nrm((DEPTH, BR_W), 0.01),
        "pool_scale": 1.0 + nrm((DEPTH, BR_W), 0.1),
        "conv_w": nrm((DEPTH, BR_W, CONV_W), CONV_W ** -0.5),
        "w_branch": nrm((DEPTH, N_BRANCH, BR_W, D_MODEL), BR_W ** -0.5),
        "w_out": nrm((DEPTH, D_MODEL, D_MODEL), 0.5 * D_MODEL ** -0.5),
        "w1": nrm((DEPTH, D_MODEL, D_FF), D_MODEL ** -0.5),
        "w3": nrm((DEPTH, D_MODEL, D_FF), D_MODEL ** -0.5),
        "w2": nrm((DEPTH, D_FF, D_MODEL), D_FF ** -0.5),
        "final_g": 1.0 + nrm((D_MODEL,), 0.1),
    }


def reference(x_prompt, x_sample, c_prompt, c_sample, cache_b1, cache_b2, cache_b3, cache_pool, cache_conv,
              ln1_g, ln2_g, w_ada, b_ada, w_in, w_gate, b_gate, a_ln_g, a_ln_b, a_ws, a_bs,
              rel_bias, pool_w, pool_b, pool_scale, conv_w, w_branch, w_out, w1, w3, w2, final_g):
    params = (ln1_g, ln2_g, w_ada, b_ada, w_in, w_gate, b_gate, a_ln_g, a_ln_b, a_ws, a_bs,
              rel_bias, pool_w, pool_b, pool_scale, conv_w, w_branch, w_out, w1, w3, w2, final_g)
    y_prompt, sp = run_trunk(x_prompt, c_prompt, None, params, 0)
    caches = (cache_b1, cache_b2, cache_b3, cache_pool, cache_conv)
    y_sample, ss = run_trunk(x_sample, c_sample, caches, params, PAST_LEN)
    return (y_prompt, y_sample, sp[0], sp[1], sp[2], sp[3], sp[4],
            ss[0], ss[1], ss[2], ss[3], ss[4], ss[5])
```

```cpp
#include <hip/hip_runtime.h>
#include <cstdio>
#include <cstdint>

#ifndef MK_MULTI_LAUNCH
#define MK_MULTI_LAUNCH 1
#endif

#define LAS __attribute__((address_space(3)))
#define GAS __attribute__((address_space(1)))
typedef unsigned short bf16_t;
typedef short bf16x8 __attribute__((ext_vector_type(8)));
typedef float f32x4 __attribute__((ext_vector_type(4)));
typedef float f32x2 __attribute__((ext_vector_type(2)));
typedef unsigned u32x4 __attribute__((ext_vector_type(4)));
typedef unsigned u32x2 __attribute__((ext_vector_type(2)));

constexpr int D = 2048, SEQ = 4096, NBP = 2, MP = NBP * SEQ, NBS = 8, TS = 4, MS = NBS * TS, MREAL = MP + MS, MPAD = 8448;
constexpr int NIN = 7680, NGATE = 8192, N1 = NIN + NGATE, DFF = 5632, N4 = 2 * DFF, BRW = 512, DEPTH = 4, NBB = NBP + NBS;
constexpr int NWAVES = 8, NTHREADS = 512;
constexpr float RMS_EPS = 1e-6f, LN_EPS = 1e-5f;
constexpr float ATT_SCALE = 0.08838834764831845f;

constexpr size_t OUT_Y = 0;
constexpr size_t OUT_B1P = (size_t)MREAL * D;
constexpr size_t OUT_B2P = OUT_B1P + (size_t)DEPTH * NBP * 128 * 1024;
constexpr size_t OUT_B3P = OUT_B2P + (size_t)DEPTH * NBP * 512 * 1024;
constexpr size_t OUT_POOLP = OUT_B3P + (size_t)DEPTH * NBP * 2048 * 1024;
constexpr size_t OUT_CONVP = OUT_POOLP + (size_t)DEPTH * NBP * 15 * 512;
constexpr size_t OUT_B1S = OUT_CONVP + (size_t)DEPTH * NBP * 2 * 512;
constexpr size_t OUT_B2S = OUT_B1S + (size_t)DEPTH * NBS * TS * 1024;
constexpr size_t OUT_B3S = OUT_B2S + (size_t)DEPTH * NBS * TS * 1024;
constexpr size_t OUT_POOLS = OUT_B3S + (size_t)DEPTH * NBS * TS * 1024;
constexpr size_t OUT_CONVS = OUT_POOLS + (size_t)DEPTH * NBS * TS * 512;
constexpr size_t OUT_CHUNKV = OUT_CONVS + (size_t)DEPTH * NBS * TS * 512;
constexpr size_t OUT_END = OUT_CHUNKV + (size_t)DEPTH * NBS * TS * 512;
static_assert(OUT_END == 39522304, "output size");

constexpr size_t MiB = 1u << 20;
constexpr size_t WS_CTL = 0, CTL_ZERO_BYTES = 1 * MiB;
constexpr size_t WS_MOD = 1 * MiB;
constexpr size_t WS_MODP = 3 * MiB;
constexpr size_t WS_POOLWT = 33 * MiB;
constexpr size_t WS_BT1 = 34 * MiB, BT1_L = (size_t)N1 * D * 2;
constexpr size_t WS_BT2 = 282 * MiB, BT2_L = (size_t)4 * D * BRW * 2;
constexpr size_t WS_BT3 = 314 * MiB, BT3_L = (size_t)D * D * 2;
constexpr size_t WS_BT4 = 346 * MiB, BT4_L = (size_t)N4 * D * 2;
constexpr size_t WS_BT5 = 522 * MiB, BT5_L = (size_t)D * DFF * 2;
constexpr size_t WS_X = 610 * MiB;
constexpr size_t WS_HN = 676 * MiB;
constexpr size_t WS_P = 709 * MiB;
constexpr size_t WS_GATES = 833 * MiB;
constexpr size_t WS_YS = 965 * MiB;
constexpr size_t WS_OG = 998 * MiB;
constexpr size_t WS_LSE = 1022 * MiB;
constexpr size_t WS_MERGED = 1023 * MiB;
constexpr size_t WS_ACC = 1056 * MiB;
constexpr size_t WS_H = 1120 * MiB;
constexpr size_t WS_END = 1211 * MiB;
static_assert(WS_BT1 + 4 * BT1_L <= WS_BT2 && WS_BT2 + 4 * BT2_L <= WS_BT3 && WS_BT3 + 4 * BT3_L <= WS_BT4 && WS_BT4 + 4 * BT4_L <= WS_BT5 && WS_BT5 + 4 * BT5_L <= WS_X, "ws map (weights)");
static_assert(WS_X + (size_t)MPAD * D * 4 <= WS_HN && WS_HN + (size_t)MPAD * D * 2 <= WS_P && WS_P + (size_t)MPAD * NIN * 2 <= WS_GATES && WS_GATES + (size_t)MPAD * NGATE * 2 <= WS_YS, "ws map (act 1)");
static_assert(WS_YS + (size_t)MPAD * D * 2 <= WS_OG && WS_OG + (size_t)3 * MP * BRW * 2 <= WS_LSE && WS_LSE + (size_t)3 * MP * 4 * 4 <= WS_MERGED && WS_MERGED + (size_t)MPAD * D * 2 <= WS_ACC, "ws map (act 2)");
static_assert(WS_ACC + (size_t)256 * 32 * 512 * 16 <= WS_H && WS_H + (size_t)MPAD * DFF * 2 <= WS_END, "ws map (act 3)");
static_assert(WS_MOD + (size_t)DEPTH * NBB * 6 * D * 4 <= WS_MODP && WS_MODP + (size_t)16 * DEPTH * NBB * 6 * D * 4 <= WS_POOLWT, "ws map (mod)");
constexpr int CW_BAR = 4096;

constexpr int RING_BYTES = 131072;
constexpr int LDSCTL_OFF = RING_BYTES, MISC_OFF = LDSCTL_OFF + 320;
constexpr int LDS_BYTES = 147456;

__device__ __forceinline__ unsigned cvt_pk_bf16(float lo, float hi) { unsigned r; asm("v_cvt_pk_bf16_f32 %0, %1, %2" : "=v"(r) : "v"(lo), "v"(hi)); return r; }
__device__ __forceinline__ float bflo(unsigned u) { return __uint_as_float(u << 16); }
__device__ __forceinline__ float bfhi(unsigned u) { return __uint_as_float(u & 0xffff0000u); }
__device__ __forceinline__ float bf1(bf16_t b) { return __uint_as_float(((unsigned)b) << 16); }
__device__ __forceinline__ void unpack8(const u32x4 w, float (&f)[8]) { f[0] = bflo(w.x); f[1] = bfhi(w.x); f[2] = bflo(w.y); f[3] = bfhi(w.y); f[4] = bflo(w.z); f[5] = bfhi(w.z); f[6] = bflo(w.w); f[7] = bfhi(w.w); }
__device__ __forceinline__ u32x4 pack8(const float (&f)[8]) { u32x4 w; w.x = cvt_pk_bf16(f[0], f[1]); w.y = cvt_pk_bf16(f[2], f[3]); w.z = cvt_pk_bf16(f[4], f[5]); w.w = cvt_pk_bf16(f[6], f[7]); return w; }
__device__ __forceinline__ float wave_sum(float v) {
#pragma unroll
    for (int o = 1; o < 64; o <<= 1) v += __shfl_xor(v, o);
    return v;
}
__device__ __forceinline__ float wave_max(float v) {
#pragma unroll
    for (int o = 1; o < 64; o <<= 1) v = fmaxf(v, __shfl_xor(v, o));
    return v;
}
__device__ __forceinline__ float sigmoidf_(float x) { return 1.0f / (1.0f + __expf(-x)); }
__device__ __forceinline__ float gelu_tanh(float x) { const float u = 0.7978845608028654f * (x + 0.044715f * x * x * x); return x / (1.0f + __expf(-2.0f * u)); }

__constant__ unsigned char BKT[3][132] = {
{0,1,2,3,4,5,6,7,8,9,10,11,12,13,14,15,16,16,16,16,16,16,17,17,17,17,17,17,17,17,18,18,18,18,18,18,18,18,18,18,19,19,19,19,19,19,19,19,19,19,19,19,19,19,20,20,20,20,20,20,20,20,20,20,20,20,20,20,20,20,20,20,20,21,21,21,21,21,21,21,21,21,21,21,21,21,21,21,21,21,21,21,21,21,21,21,21,21,21,22,22,22,22,22,22,22,22,22,22,22,22,22,22,22,22,22,22,22,22,22,22,22,22,22,22,22,22,22,22,0,0,0},
{0,4,8,12,16,16,17,17,18,18,19,19,19,19,20,20,20,20,20,21,21,21,21,21,21,22,22,22,22,22,22,22,22,22,23,23,23,23,23,23,23,23,23,23,23,23,24,24,24,24,24,24,24,24,24,24,24,24,24,24,24,24,25,25,25,25,25,25,25,25,25,25,25,25,25,25,25,25,25,25,25,25,25,26,26,26,26,26,26,26,26,26,26,26,26,26,26,26,26,26,26,26,26,26,26,26,26,26,26,26,26,26,26,27,27,27,27,27,27,27,27,27,27,27,27,27,27,27,27,0,0,0},
{0,16,18,19,20,21,21,22,22,23,23,23,24,24,24,24,25,25,25,25,25,26,26,26,26,26,26,26,26,27,27,27,27,27,27,27,27,27,27,28,28,28,28,28,28,28,28,28,28,28,28,28,29,29,29,29,29,29,29,29,29,29,29,29,29,29,29,29,29,29,30,30,30,30,30,30,30,30,30,30,30,30,30,30,30,30,30,30,30,30,30,30,30,30,30,31,31,31,31,31,31,31,31,31,31,31,31,31,31,31,31,31,31,31,31,31,31,31,31,31,31,31,31,31,31,31,31,31,31,0,0,0}};

#define XB_TMO      128
#define XB_XCNT(j)  (256  + 64 * (j))
#define XB_XSUB(j)  (1280 + 64 * (j))
#define XB_XGEN(j)  (2304 + 64 * (j))
#define XB_TOP      3328
#define XB_TOPGEN   3392
#define XCD_BAR_WORDS 3456
#define XB_SPIN_CAP (1u << 18)
__device__ __forceinline__ unsigned xb_ld(unsigned* p)              { return __hip_atomic_load(p, __ATOMIC_RELAXED, __HIP_MEMORY_SCOPE_AGENT); }
__device__ __forceinline__ unsigned xb_add(unsigned* p, unsigned v) { return __hip_atomic_fetch_add(p, v, __ATOMIC_RELAXED, __HIP_MEMORY_SCOPE_AGENT); }
__device__ __forceinline__ unsigned xb_xcc_id() { return (unsigned)__builtin_amdgcn_s_getreg((3 << 11) | 20) & 0xFu; }
#define XB_SPIN(cond, bar) do { unsigned _sp = 0; while (cond) { __builtin_amdgcn_s_sleep(1); \
    if ((++_sp & 255u) == 0u) { if (xb_ld(&(bar)[XB_TMO])) break; if (_sp > XB_SPIN_CAP) { atomicAdd(&(bar)[XB_TMO], 1u); break; } } } } while (0)
struct XcdBarrier { unsigned* bar; unsigned x; volatile LAS unsigned* st; };
__device__ __forceinline__ XcdBarrier xcd_barrier_post(unsigned* bar, volatile LAS unsigned* st) {
    XcdBarrier b; b.bar = bar; b.x = xb_xcc_id(); b.st = st;
    if (threadIdx.x == 0) (void)xb_add(&bar[XB_XCNT(b.x)], 1u);
    return b;
}
__device__ __forceinline__ void xcd_barrier_complete(unsigned* bar, unsigned x, unsigned& nloc, unsigned& nx) {
    const unsigned G = gridDim.x * gridDim.y * gridDim.z;
    unsigned sum, cnt, mine, sp = 0u;
    for (;;) {
        sum = 0u; cnt = 0u; mine = 0u;
#pragma unroll
        for (unsigned j = 0; j < 16; ++j) { const unsigned c = xb_ld(&bar[XB_XCNT(j)]); sum += c; cnt += (c > 0u) ? 1u : 0u; mine = (j == x) ? c : mine; }
        if (sum == G) break;
        __builtin_amdgcn_s_sleep(1);
        if ((++sp & 255u) == 0u) { if (xb_ld(&bar[XB_TMO])) break; if (sp > XB_SPIN_CAP) { atomicAdd(&bar[XB_TMO], 1u); break; } }
    }
    nloc = mine > 0u ? mine : 1u; nx = cnt > 0u ? cnt : 1u;
}
__device__ __forceinline__ void xcd_barrier(const XcdBarrier& b) {
    asm volatile("s_waitcnt vmcnt(0)" ::: "memory");
    __syncthreads();
    if (threadIdx.x == 0) {
        unsigned* bar = b.bar;
        __builtin_amdgcn_s_waitcnt(0);
        unsigned nloc = b.st[0], nx = b.st[1];
        if (nloc == 0u) { xcd_barrier_complete(bar, b.x, nloc, nx); b.st[0] = nloc; b.st[1] = nx; }
        const unsigned old = xb_add(&bar[XB_XSUB(b.x)], 1u);
        const unsigned gen = old / nloc;
        if (old + 1u == (gen + 1u) * nloc) {
            __builtin_amdgcn_fence(__ATOMIC_RELEASE, "agent");
            asm volatile("s_waitcnt vmcnt(0)" ::: "memory");
            const unsigned og = xb_add(&bar[XB_TOP], 1u);
            const unsigned tg = og / nx;
            if (og + 1u == (tg + 1u) * nx) xb_add(&bar[XB_TOPGEN], 1u);
            else XB_SPIN(xb_ld(&bar[XB_TOPGEN]) == tg, bar);
            __builtin_amdgcn_fence(__ATOMIC_ACQUIRE, "agent");
            xb_add(&bar[XB_XGEN(b.x)], 1u);
            asm volatile("s_waitcnt vmcnt(0)" ::: "memory");
        } else {
            XB_SPIN(xb_ld(&bar[XB_XGEN(b.x)]) == gen, bar);
            __builtin_amdgcn_fence(__ATOMIC_ACQUIRE, "agent");
            asm volatile("s_waitcnt vmcnt(0)" ::: "memory");
        }
    }
    __syncthreads();
}

namespace pg8 {
constexpr int BM = 256, BK = 64, HALF = 128, HTB = HALF * BK * 2, STAGE_BYTES = 8 * HTB, NXCD = 8, WGM = 8;
__host__ __device__ __forceinline__ int lds_byte(int r, int c) { const int st = (r >> 4) * 2 + (c >> 5), rr = r & 15, cc = c & 31, ob = rr * 64 + cc * 2; return st * 1024 + (ob ^ (((ob >> 9) & 1) << 5)); }
__host__ __device__ __forceinline__ void stage_rc(int b, int& R, int& C) { const int st = b / 1024, sb = b % 1024, swz = sb ^ (((sb >> 9) & 1) << 5); R = (st >> 1) * 16 + swz / 64; C = (st & 1) * 32 + (swz % 64) / 2; }
__host__ __device__ __forceinline__ int perm32(int rho) { const int n = rho >> 4, i = rho & 15; return 8 * (i >> 2) + 4 * n + (i & 3); }

struct Unit { int pm, pn, tag; size_t aoff, boff; };
struct Gemm { const bf16_t* A; const bf16_t* Bt; int lda, ldb, K; };

struct StaticOrder {
    int nM, nN, nwg, G, c; size_t astep, bstep;
    __device__ void init(int nM_, int nN_, int G_, int c_, int lda, int ldb) { nM = nM_; nN = nN_; nwg = nM * nN; G = G_; c = c_; astep = (size_t)BM * lda * 2; bstep = (size_t)BM * ldb * 2; }
    __device__ bool next(int i, Unit& u) const {
        const long L = (long)i * G + c; if (L >= nwg) return false;
        int wgid = (int)L; { const int q = nwg / NXCD, r = nwg % NXCD, xcd = wgid % NXCD, off = wgid / NXCD; wgid = (xcd < r ? xcd * (q + 1) : r * (q + 1) + (xcd - r) * q) + off; }
        const int nig = WGM * nN, gid = wgid / nig, fm = gid * WGM, gsz = (nM - fm) < WGM ? (nM - fm) : WGM;
        u.pm = fm + ((wgid % nig) % gsz); u.pn = (wgid % nig) / gsz; u.tag = 0; u.aoff = (size_t)u.pm * astep; u.boff = (size_t)u.pn * bstep; return true;
    }
};
struct BranchOrder {
    int G, vc, ntiles;
    __device__ bool next(int i, Unit& u) const {
        const int T = vc + G * (i >> 2); if (T >= ntiles) return false;
        const int g = i & 3; u.pm = T >> 3; u.pn = T & 7; u.tag = g;
        u.aoff = ((size_t)u.pm * BM * D + (size_t)g * BRW) * 2; u.boff = ((size_t)g * D + (size_t)u.pn * BM) * BRW * 2; return true;
    }
};

template <class Epi, class Sched>
__device__ __forceinline__ void gemm_phase(LAS unsigned char* lds, const Gemm g, const Sched& S, const Epi& E) {
    int lane = threadIdx.x & 63, wid = __builtin_amdgcn_readfirstlane(threadIdx.x >> 6); asm volatile("" : "+v"(lane)); asm volatile("" : "+s"(wid));
    const int tid = wid * 64 + lane, wr = wid >> 2, wc = wid & 3, fr = lane & 15, fq = lane >> 4;
    const int K = g.K, nt = K / BK;
    unsigned voffA[2], voffB[2];
#pragma unroll
    for (int i = 0; i < 2; ++i) { int R, C; stage_rc(tid * 16 + i * 8192, R, C); const int Rb = Epi::PERM ? ((R & ~31) + perm32(R & 31)) : R;
        voffA[i] = (unsigned)(R * g.lda + C) * 2u; voffB[i] = (unsigned)(Rb * g.ldb + C) * 2u; }
    const size_t kstep = (size_t)(BK * 2);
    const size_t hA = (size_t)HALF * g.lda * 2, hB = (size_t)HALF * g.ldb * 2;
    const unsigned ldsw = (unsigned)wid * 1024u;
    const int aoff = lds_byte(wr * 64 + fr, fq * 8), boff = lds_byte(wc * 32 + fr, fq * 8);
#define PG8_SA(b, h) (((b) * 2 + (h)) * HTB)
#define PG8_SB(b, h) ((4 + (b) * 2 + (h)) * HTB)
#define PG8_STAGE(bufoff, gbase, voff) do { _Pragma("unroll") for (int _i = 0; _i < 2; ++_i) \
        __builtin_amdgcn_global_load_lds((const unsigned*)((const char*)(gbase) + (voff)[_i]), (LAS unsigned*)(lds + (bufoff) + ldsw + _i * 8192), 16, 0, 0); } while (0)
#define PG8_LDA(dst, b, h) do { _Pragma("unroll") for (int m = 0; m < 4; ++m) _Pragma("unroll") for (int k = 0; k < 2; ++k) dst[m][k] = *(const LAS bf16x8*)(lds + PG8_SA(b, h) + aoff + m * 2048 + k * 1024); } while (0)
#define PG8_LDB(dst, b, h) do { _Pragma("unroll") for (int n = 0; n < 2; ++n) _Pragma("unroll") for (int k = 0; k < 2; ++k) dst[n][k] = *(const LAS bf16x8*)(lds + PG8_SB(b, h) + boff + n * 2048 + k * 1024); } while (0)
#define PG8_MMA(ai, bj, At, Bt) do { __builtin_amdgcn_s_setprio(1); _Pragma("unroll") for (int m = 0; m < 4; ++m) _Pragma("unroll") for (int n = 0; n < 2; ++n) _Pragma("unroll") for (int k = 0; k < 2; ++k) \
        acc[ai][bj][m][n] = __builtin_amdgcn_mfma_f32_16x16x32_bf16(Bt[n][k], At[m][k], acc[ai][bj][m][n], 0, 0, 0); __builtin_amdgcn_s_setprio(0); } while (0)
#define PG8_WAIT_V(n) asm volatile("s_waitcnt vmcnt(" #n ")" ::: "memory")
#define PG8_WAIT_L(n) asm volatile("s_waitcnt lgkmcnt(" #n ")" ::: "memory")
#define PG8_BAR __builtin_amdgcn_s_barrier()
#define PG8_SCHED __builtin_amdgcn_sched_barrier(0)
    Unit cur, nxt; int ui = 0;
    if (!S.next(0, cur)) return;
    f32x4 acc[2][2][4][2];
#pragma unroll
    for (int a = 0; a < 2; ++a)
#pragma unroll
        for (int b = 0; b < 2; ++b)
#pragma unroll
            for (int m = 0; m < 4; ++m)
#pragma unroll
                for (int n = 0; n < 2; ++n) acc[a][b][m][n] = (f32x4){0.f, 0.f, 0.f, 0.f};
    bf16x8 At[4][2], B0[2][2], B1[2][2];
    const char* cA = (const char*)g.A + cur.aoff; const char* cB = (const char*)g.Bt + cur.boff;
    PG8_STAGE(PG8_SB(0, 0), cB, voffB); PG8_STAGE(PG8_SB(0, 1), cB + hB, voffB); PG8_STAGE(PG8_SA(0, 0), cA, voffA); PG8_STAGE(PG8_SA(0, 1), cA + hA, voffA);
    if (wr == 1) PG8_BAR;
    PG8_WAIT_V(2); PG8_BAR;
    PG8_STAGE(PG8_SB(1, 0), cB + kstep, voffB); PG8_STAGE(PG8_SA(1, 0), cA + kstep, voffA); PG8_STAGE(PG8_SB(1, 1), cB + hB + kstep, voffB);
    PG8_WAIT_V(6); PG8_BAR;
    for (;;) {
        const bool has_next = S.next(ui + 1, nxt);
        const char* nA = has_next ? (const char*)g.A + nxt.aoff : cA; const char* nB = has_next ? (const char*)g.Bt + nxt.boff : cB;
        for (int t = 0; t < nt; t += 2) {
            const bool last = (t == nt - 2);
            const char* a1 = cA + (size_t)(t + 1) * kstep;
            const char* a2 = last ? nA : cA + (size_t)(t + 2) * kstep; const char* b2 = last ? nB : cB + (size_t)(t + 2) * kstep;
            const char* a3 = a2 + kstep; const char* b3 = b2 + kstep;
            PG8_LDB(B0, 0, 0); PG8_LDB(B1, 0, 1); PG8_SCHED; PG8_LDA(At, 0, 0); PG8_STAGE(PG8_SA(1, 1), a1 + hA, voffA);
            PG8_WAIT_V(8); PG8_WAIT_L(0); PG8_BAR; PG8_MMA(0, 0, At, B0); PG8_MMA(0, 1, At, B1); PG8_BAR; PG8_SCHED;
            PG8_LDA(At, 0, 1); PG8_STAGE(PG8_SB(0, 0), b2, voffB); PG8_STAGE(PG8_SB(0, 1), b2 + hB, voffB); PG8_STAGE(PG8_SA(0, 0), a2, voffA);
            PG8_WAIT_V(8); PG8_WAIT_L(0); PG8_BAR; PG8_MMA(1, 0, At, B0); PG8_MMA(1, 1, At, B1); PG8_BAR; PG8_SCHED;
            PG8_LDB(B0, 1, 0); PG8_LDB(B1, 1, 1); PG8_SCHED; PG8_LDA(At, 1, 0); PG8_STAGE(PG8_SA(0, 1), a2 + hA, voffA);
            PG8_WAIT_V(8); PG8_WAIT_L(0); PG8_BAR; PG8_MMA(0, 0, At, B0); PG8_MMA(0, 1, At, B1); PG8_BAR; PG8_SCHED;
            PG8_LDA(At, 1, 1); PG8_STAGE(PG8_SB(1, 0), b3, voffB); PG8_STAGE(PG8_SB(1, 1), b3 + hB, voffB); PG8_STAGE(PG8_SA(1, 0), a3, voffA);
            PG8_WAIT_V(8); PG8_WAIT_L(0); PG8_BAR; PG8_MMA(1, 0, At, B0); PG8_MMA(1, 1, At, B1); PG8_BAR; PG8_SCHED;
        }
        if (wr == 0) PG8_BAR;
        E(acc, cur, wr, wc, fr, fq);
        if (!has_next) break;
#pragma unroll
        for (int a = 0; a < 2; ++a)
#pragma unroll
            for (int b = 0; b < 2; ++b)
#pragma unroll
                for (int m = 0; m < 4; ++m)
#pragma unroll
                    for (int n = 0; n < 2; ++n) acc[a][b][m][n] = (f32x4){0.f, 0.f, 0.f, 0.f};
        cur = nxt; cA = nA; cB = nB; ++ui;
        if (wr == 1) PG8_BAR;
    }
    PG8_WAIT_V(0);
    PG8_BAR;
#undef PG8_SA
#undef PG8_SB
#undef PG8_STAGE
#undef PG8_LDA
#undef PG8_LDB
#undef PG8_MMA
#undef PG8_WAIT_V
#undef PG8_WAIT_L
#undef PG8_BAR
#undef PG8_SCHED
}

struct Epi1 {
    static constexpr bool PERM = true;
    bf16_t* P; bf16_t* G; const float* bg;
    __device__ __forceinline__ void operator()(const f32x4 (&acc)[2][2][4][2], const Unit& u, int wr, int wc, int fr, int fq) const {
        const int row0 = u.pm * BM + wr * 64 + fr, ct = u.pn * BM, cw = wc * 32 + 8 * fq;
        if (ct < NIN) {
            const bool gelu = ct < 1024;
#pragma unroll
            for (int ai = 0; ai < 2; ++ai)
#pragma unroll
                for (int m = 0; m < 4; ++m) { bf16_t* rowp = P + (size_t)(row0 + ai * HALF + m * 16) * NIN + ct + cw;
#pragma unroll
                    for (int bj = 0; bj < 2; ++bj) { f32x4 v0 = acc[ai][bj][m][0], v1 = acc[ai][bj][m][1];
                        if (gelu) {
#pragma unroll
                            for (int j = 0; j < 4; ++j) { v0[j] = gelu_tanh(v0[j]); v1[j] = gelu_tanh(v1[j]); } }
                        u32x4 w; w.x = cvt_pk_bf16(v0[0], v0[1]); w.y = cvt_pk_bf16(v0[2], v0[3]); w.z = cvt_pk_bf16(v1[0], v1[1]); w.w = cvt_pk_bf16(v1[2], v1[3]);
                        *(u32x4*)(rowp + bj * HALF) = w; } }
        } else {
            const int cg = ct - NIN + cw;
            f32x4 bv[2][2];
#pragma unroll
            for (int bj = 0; bj < 2; ++bj)
#pragma unroll
                for (int n = 0; n < 2; ++n) bv[bj][n] = *(const f32x4*)(bg + cg + bj * HALF + 4 * n);
#pragma unroll
            for (int ai = 0; ai < 2; ++ai)
#pragma unroll
                for (int m = 0; m < 4; ++m) { bf16_t* rowp = G + (size_t)(row0 + ai * HALF + m * 16) * NGATE + cg;
#pragma unroll
                    for (int bj = 0; bj < 2; ++bj) { f32x4 v0 = acc[ai][bj][m][0] + bv[bj][0], v1 = acc[ai][bj][m][1] + bv[bj][1];
#pragma unroll
                        for (int j = 0; j < 4; ++j) { v0[j] = sigmoidf_(v0[j]); v1[j] = sigmoidf_(v1[j]); }
                        u32x4 w; w.x = cvt_pk_bf16(v0[0], v0[1]); w.y = cvt_pk_bf16(v0[2], v0[3]); w.z = cvt_pk_bf16(v1[0], v1[1]); w.w = cvt_pk_bf16(v1[2], v1[3]);
                        *(u32x4*)(rowp + bj * HALF) = w; } }
        }
    }
};
struct Epi2 {
    static constexpr bool PERM = true;
    const bf16_t* G; bf16_t* O; float* slab;
    __device__ __forceinline__ void operator()(const f32x4 (&acc)[2][2][4][2], const Unit& u, int wr, int wc, int fr, int fq) const {
        const int g = u.tag, row0 = u.pm * BM + wr * 64 + fr, cw = u.pn * BM + wc * 32 + 8 * fq;
        float* sl = slab + (size_t)threadIdx.x * 4; asm volatile("" : "+v"(sl));
#pragma unroll
        for (int ai = 0; ai < 2; ++ai)
#pragma unroll
            for (int m = 0; m < 4; ++m) { const size_t row = (size_t)(row0 + ai * HALF + m * 16);
#pragma unroll
                for (int bj = 0; bj < 2; ++bj) {
                    const u32x4 gw = *(const u32x4*)(G + row * NGATE + (size_t)g * D + cw + bj * HALF);
                    f32x4 v0 = acc[ai][bj][m][0] * (f32x4){bflo(gw.x), bfhi(gw.x), bflo(gw.y), bfhi(gw.y)};
                    f32x4 v1 = acc[ai][bj][m][1] * (f32x4){bflo(gw.z), bfhi(gw.z), bflo(gw.w), bfhi(gw.w)};
                    float* s0 = sl + (size_t)((((ai * 4 + m) * 2 + bj) * 2 + 0) * 2048), *s1 = s0 + 2048;
                    if (g > 0) { v0 += *(const f32x4*)s0; v1 += *(const f32x4*)s1; }
                    if (g < 3) { *(f32x4*)s0 = v0; *(f32x4*)s1 = v1; }
                    else { u32x4 w; w.x = cvt_pk_bf16(v0[0], v0[1]); w.y = cvt_pk_bf16(v0[2], v0[3]); w.z = cvt_pk_bf16(v1[0], v1[1]); w.w = cvt_pk_bf16(v1[2], v1[3]);
                        *(u32x4*)(O + row * D + cw + bj * HALF) = w; } }
                asm volatile("" ::: "memory"); }
    }
};
struct EpiRes {
    static constexpr bool PERM = false;
    float* X; const float* modl; int jg;
    __device__ __forceinline__ void operator()(const f32x4 (&acc)[2][2][4][2], const Unit& u, int wr, int wc, int fr, int fq) const {
        const int row0 = u.pm * BM + wr * 64 + fr, col0 = u.pn * BM + wc * 32 + 4 * fq;
#pragma unroll
        for (int ai = 0; ai < 2; ++ai)
#pragma unroll
            for (int m = 0; m < 4; ++m) { const int row = row0 + ai * HALF + m * 16;
                int bb = row < MP ? (row >> 12) : (NBP + ((row - MP) >> 2)); bb = bb < NBB ? bb : NBB - 1;
                const float* gp = modl + (size_t)(bb * 6 + jg) * D + col0; float* xp = X + (size_t)row * D + col0;
#pragma unroll
                for (int bj = 0; bj < 2; ++bj)
#pragma unroll
                    for (int n = 0; n < 2; ++n) { const f32x4 gv = *(const f32x4*)(gp + bj * HALF + n * 16); const f32x4 xv = *(const f32x4*)(xp + bj * HALF + n * 16);
                        *(f32x4*)(xp + bj * HALF + n * 16) = xv + gv * acc[ai][bj][m][n]; }
                asm volatile("" ::: "memory"); }
    }
};
struct EpiSwi {
    static constexpr bool PERM = true;
    bf16_t* H;
    __device__ __forceinline__ void operator()(const f32x4 (&acc)[2][2][4][2], const Unit& u, int wr, int wc, int fr, int fq) const {
        const int row0 = u.pm * BM + wr * 64 + fr, c0 = u.pn * HALF + wc * 32 + 8 * fq;
#pragma unroll
        for (int ai = 0; ai < 2; ++ai)
#pragma unroll
            for (int m = 0; m < 4; ++m) { bf16_t* rowp = H + (size_t)(row0 + ai * HALF + m * 16) * DFF + c0;
                f32x4 v0, v1;
#pragma unroll
                for (int j = 0; j < 4; ++j) { const float a0 = acc[ai][0][m][0][j], a1 = acc[ai][0][m][1][j]; v0[j] = a0 * sigmoidf_(a0) * acc[ai][1][m][0][j]; v1[j] = a1 * sigmoidf_(a1) * acc[ai][1][m][1][j]; }
                u32x4 w; w.x = cvt_pk_bf16(v0[0], v0[1]); w.y = cvt_pk_bf16(v0[2], v0[3]); w.z = cvt_pk_bf16(v1[0], v1[1]); w.w = cvt_pk_bf16(v1[2], v1[3]);
                *(u32x4*)rowp = w; }
    }
};
}

enum { I_XP = 0, I_XS, I_CP, I_CS, I_CB1, I_CB2, I_CB3, I_CPOOL, I_CCONV, I_LN1G, I_LN2G, I_WADA, I_BADA, I_WIN, I_WGATE, I_BGATE, I_ALNG, I_ALNB, I_AWS, I_ABS, I_RELB, I_POOLW, I_POOLB, I_POOLS, I_CONVW, I_WBR, I_WOUT, I_W1, I_W3, I_W2, I_FING };
__device__ __forceinline__ const float* inp(int i) {
    const __attribute__((address_space(4))) char* kp = (const __attribute__((address_space(4))) char*)__builtin_amdgcn_kernarg_segment_ptr();
    return *(const float* const volatile __attribute__((address_space(4)))*)(kp + 8 * i);
}
struct Frame {
    LAS unsigned char* lds;
    int tid, lane, wave, vcu, G;
    float* out; unsigned char* ws;
    __device__ __forceinline__ float* MOD() const { return (float*)(ws + WS_MOD); }
    __device__ __forceinline__ float* MODP() const { return (float*)(ws + WS_MODP); }
    __device__ __forceinline__ float* X() const { return (float*)(ws + WS_X); }
    __device__ __forceinline__ float* LSE() const { return (float*)(ws + WS_LSE); }
    __device__ __forceinline__ float* ACC() const { return (float*)(ws + WS_ACC); }
    __device__ __forceinline__ bf16_t* POOLWT() const { return (bf16_t*)(ws + WS_POOLWT); }
    __device__ __forceinline__ bf16_t* HN() const { return (bf16_t*)(ws + WS_HN); }
    __device__ __forceinline__ bf16_t* P() const { return (bf16_t*)(ws + WS_P); }
    __device__ __forceinline__ bf16_t* GATES() const { return (bf16_t*)(ws + WS_GATES); }
    __device__ __forceinline__ bf16_t* YS() const { return (bf16_t*)(ws + WS_YS); }
    __device__ __forceinline__ bf16_t* OG() const { return (bf16_t*)(ws + WS_OG); }
    __device__ __forceinline__ bf16_t* MERGED() const { return (bf16_t*)(ws + WS_MERGED); }
    __device__ __forceinline__ bf16_t* H() const { return (bf16_t*)(ws + WS_H); }
};

#define OPAQUE_IDS(F) int lane = (F).lane, wave = (F).wave; asm volatile("" : "+v"(lane)); asm volatile("" : "+s"(wave)); const int tid = wave * 64 + lane; (void)tid
__device__ __forceinline__ unsigned f2bf(float f) { unsigned u = __float_as_uint(f); return (u + 0x7fffu + ((u >> 16) & 1u)) >> 16; }
__device__ __forceinline__ unsigned pk2(float lo, float hi) { return f2bf(lo) | (f2bf(hi) << 16); }
__device__ __forceinline__ void transpose_item(const float* W, int N, int k0, int n0, bf16_t* WT, int ldk, int drow0, LAS float* scr, int lane) {
#pragma unroll 8
    for (int i = 0; i < 32; ++i) { const int kk = 2 * i + (lane >> 5); scr[kk * 33 + (lane & 31)] = W[(size_t)(k0 + kk) * N + n0 + (lane & 31)]; }
    asm volatile("s_waitcnt lgkmcnt(0)" ::: "memory");
    const int c = lane & 7;
#pragma unroll
    for (int j = 0; j < 4; ++j) { const int n = (lane >> 3) + 8 * j; const LAS float* s = scr + (8 * c) * 33 + n;
        u32x4 o; o.x = pk2(s[0 * 33], s[1 * 33]); o.y = pk2(s[2 * 33], s[3 * 33]); o.z = pk2(s[4 * 33], s[5 * 33]); o.w = pk2(s[6 * 33], s[7 * 33]);
        *(u32x4*)(WT + (size_t)(drow0 + n) * ldk + k0 + 8 * c) = o; }
    asm volatile("s_waitcnt lgkmcnt(0)" ::: "memory");
}
__device__ __forceinline__ void p0a_phase(const Frame& F) {
    OPAQUE_IDS(F);
    {
        LAS float* sl = (LAS float*)F.lds;
        LAS float* red = (LAS float*)(F.lds + 8192);
        const float* cpr = inp(I_CP); const float* csm = inp(I_CS); const float* wada = inp(I_WADA);
        for (int u = F.vcu; u < 768; u += F.G) {
            const int l = u / 192, rem = u % 192, cb = rem >> 4, ks = rem & 15;
            __syncthreads();
            for (int i = tid; i < 1280; i += NTHREADS) { const int bb = i >> 7, kk = i & 127;
                const float c = bb < NBP ? cpr[bb * D + ks * 128 + kk] : csm[(bb - NBP) * D + ks * 128 + kk];
                sl[i] = c / (1.0f + __expf(-c)); }
            __syncthreads();
            const int ct = tid & 255, kh = tid >> 8;
            const float* wp = wada + ((size_t)(l * D + ks * 128 + kh * 64)) * (6 * D) + cb * 1024 + ct * 4;
            f32x4 acc[NBB];
#pragma unroll
            for (int b = 0; b < NBB; ++b) acc[b] = (f32x4){0.f, 0.f, 0.f, 0.f};
#pragma unroll 8
            for (int kk = 0; kk < 64; ++kk) { const f32x4 w = *(const f32x4*)(wp + (size_t)kk * (6 * D));
#pragma unroll
                for (int b = 0; b < NBB; ++b) acc[b] += sl[b * 128 + kh * 64 + kk] * w; }
            if (kh == 1) {
#pragma unroll
                for (int b = 0; b < NBB; ++b) *(LAS f32x4*)(red + (ct * NBB + b) * 4) = acc[b]; }
            __syncthreads();
            if (kh == 0) {
#pragma unroll
                for (int b = 0; b < NBB; ++b) { const f32x4 o = acc[b] + *(const LAS f32x4*)(red + (ct * NBB + b) * 4);
                    *(f32x4*)(F.MODP() + ((size_t)((ks * DEPTH + l) * NBB + b)) * (6 * D) + cb * 1024 + ct * 4) = o; } }
        }
        __syncthreads();
    }
    {
        LAS float* scr = (LAS float*)(F.lds + wave * 16384);
        const int gw = F.vcu * NWAVES + wave, NGW = F.G * NWAVES;
        constexpr int C_IN = 32 * (NIN / 32), C_GATE = 32 * (NGATE / 32), C_BR = 8 * (D / 32), C_OUT = 32 * (D / 32), C_W1 = 32 * (DFF / 32), C_W2 = (DFF / 64) * (D / 32), C_PW = 2 * 4;
        constexpr int C_LAYER = C_IN + C_GATE + 4 * C_BR + C_OUT + 2 * C_W1 + C_W2 + 4 * C_PW;
        for (int it = gw; it < DEPTH * C_LAYER; it += NGW) {
            const int l = it / C_LAYER; int r = it % C_LAYER;
            if (r < C_IN) { const int nblk = NIN / 32, kb = r / nblk, nb = r % nblk; transpose_item(inp(I_WIN) + (size_t)l * D * NIN, NIN, 64 * kb, 32 * nb, (bf16_t*)(F.ws + WS_BT1 + l * BT1_L), D, 32 * nb, scr, lane); continue; } r -= C_IN;
            if (r < C_GATE) { const int nblk = NGATE / 32, kb = r / nblk, nb = r % nblk; transpose_item(inp(I_WGATE) + (size_t)l * D * NGATE, NGATE, 64 * kb, 32 * nb, (bf16_t*)(F.ws + WS_BT1 + l * BT1_L), D, NIN + 32 * nb, scr, lane); continue; } r -= C_GATE;
            if (r < 4 * C_BR) { const int g = r / C_BR, rr = r % C_BR, nblk = D / 32, kb = rr / nblk, nb = rr % nblk;
                transpose_item(inp(I_WBR) + ((size_t)(l * 4 + g)) * BRW * D, D, 64 * kb, 32 * nb, (bf16_t*)(F.ws + WS_BT2 + l * BT2_L) + (size_t)g * D * BRW, BRW, 32 * nb, scr, lane); continue; } r -= 4 * C_BR;
            if (r < C_OUT) { const int nblk = D / 32, kb = r / nblk, nb = r % nblk; transpose_item(inp(I_WOUT) + (size_t)l * D * D, D, 64 * kb, 32 * nb, (bf16_t*)(F.ws + WS_BT3 + l * BT3_L), D, 32 * nb, scr, lane); continue; } r -= C_OUT;
            if (r < 2 * C_W1) { const int which = r / C_W1, rr = r % C_W1, nblk = DFF / 32, kb = rr / nblk, nb = rr % nblk, n0 = 32 * nb;
                transpose_item((which ? inp(I_W3) : inp(I_W1)) + (size_t)l * D * DFF, DFF, 64 * kb, n0, (bf16_t*)(F.ws + WS_BT4 + l * BT4_L), D, (n0 >> 7) * 256 + which * 128 + (n0 & 127), scr, lane); continue; } r -= 2 * C_W1;
            if (r < C_W2) { const int nblk = D / 32, kb = r / nblk, nb = r % nblk; transpose_item(inp(I_W2) + (size_t)l * DFF * D, D, 64 * kb, 32 * nb, (bf16_t*)(F.ws + WS_BT5 + l * BT5_L), DFF, 32 * nb, scr, lane); continue; } r -= C_W2;
            { const int g = r / C_PW, rr = r % C_PW, kb = rr / 4, nb = rr % 4;
                transpose_item(inp(I_POOLW) + ((size_t)(l * 4 + g)) * 128 * 128, 128, 64 * kb, 32 * nb, F.POOLWT() + ((size_t)(l * 4 + g)) * 128 * 128, 128, 32 * nb, scr, lane); }
        }
        const float* xpr = inp(I_XP); const float* xsm = inp(I_XS);
        for (int row = gw; row < MREAL; row += NGW) {
            const f32x4* src = (const f32x4*)(row < MP ? xpr + (size_t)row * D : xsm + (size_t)(row - MP) * D) + lane; f32x4* dst = (f32x4*)(F.X() + (size_t)row * D) + lane;
#pragma unroll
            for (int j = 0; j < 8; ++j) dst[64 * j] = src[64 * j];
        }
    }
}
__device__ __forceinline__ void p0b_phase(const Frame& F) {
    const int n = DEPTH * NBB * 6 * D;
    const float* bada = inp(I_BADA); const float* l1g = inp(I_LN1G); const float* l2g = inp(I_LN2G);
    OPAQUE_IDS(F);
    for (int i = F.vcu * NTHREADS + tid; i < n; i += F.G * NTHREADS) {
        const int k = i & (D - 1), j = (i >> 11) % 6, bb = (i / (6 * D)) % NBB, l = i / (NBB * 6 * D), col = j * D + k;
        float s = bada[l * 6 * D + col];
#pragma unroll
        for (int ks = 0; ks < 16; ++ks) s += F.MODP()[((size_t)((ks * DEPTH + l) * NBB + bb)) * (6 * D) + col];
        if (j == 1) s = l1g[l * D + k] * (1.0f + s);
        if (j == 4) s = l2g[l * D + k] * (1.0f + s);
        F.MOD()[i] = s;
    }
}
__device__ __forceinline__ void norm_phase(const Frame& F, const float* modl, int jS, int jSH) {
    OPAQUE_IDS(F);
    const int gw = F.vcu * NWAVES + wave, NGW = F.G * NWAVES;
    for (int row = gw; row < MREAL; row += NGW) {
        const int bb = row < MP ? (row >> 12) : (NBP + ((row - MP) >> 2));
        const f32x4* xr = (const f32x4*)(F.X() + (size_t)row * D) + lane;
        f32x4 v[8]; float ss = 0.f;
#pragma unroll
        for (int j = 0; j < 8; ++j) { v[j] = xr[64 * j]; ss += (v[j].x * v[j].x + v[j].y * v[j].y) + (v[j].z * v[j].z + v[j].w * v[j].w); }
        const float rstd = 1.0f / sqrtf(wave_sum(ss) * (1.0f / D) + RMS_EPS);
        const f32x4* sp = (const f32x4*)(modl + (size_t)(bb * 6 + jS) * D) + lane; const f32x4* hp = (const f32x4*)(modl + (size_t)(bb * 6 + jSH) * D) + lane;
        u32x2* o = (u32x2*)(F.HN() + (size_t)row * D) + lane;
#pragma unroll
        for (int j = 0; j < 8; ++j) { const f32x4 s = sp[64 * j], h = hp[64 * j]; const f32x4 y = v[j] * rstd * s + h;
            u32x2 w; w.x = cvt_pk_bf16(y.x, y.y); w.y = cvt_pk_bf16(y.z, y.w); o[64 * j] = w; }
    }
}
__device__ __forceinline__ void final_norm_phase(const Frame& F) {
    OPAQUE_IDS(F);
    const int gw = F.vcu * NWAVES + wave, NGW = F.G * NWAVES;
    const float* fing = inp(I_FING);
    for (int row = gw; row < MREAL; row += NGW) {
        const f32x4* xr = (const f32x4*)(F.X() + (size_t)row * D) + lane;
        f32x4 v[8]; float ss = 0.f;
#pragma unroll
        for (int j = 0; j < 8; ++j) { v[j] = xr[64 * j]; ss += (v[j].x * v[j].x + v[j].y * v[j].y) + (v[j].z * v[j].z + v[j].w * v[j].w); }
        const float rstd = 1.0f / sqrtf(wave_sum(ss) * (1.0f / D) + RMS_EPS);
        const f32x4* gp = (const f32x4*)fing + lane; f32x4* o = (f32x4*)(F.out + OUT_Y + (size_t)row * D) + lane;
#pragma unroll
        for (int j = 0; j < 8; ++j) o[64 * j] = v[j] * rstd * gp[64 * j];
    }
}

constexpr int TP = 272;
constexpr int L_KBUF = 0, L_VRAW = 128 * TP, L_VT = 2 * 128 * TP, L_BT = 3 * 128 * TP;
template <bool PERMK> __device__ __forceinline__ void lds_transpose(LAS unsigned char* raw, LAS unsigned char* vt, int tid) {
#pragma unroll
    for (int i = 0; i < 4; ++i) { const int task = tid + NTHREADS * i, c = task & 127, sq = task >> 7, s = sq >> 2, q = sq & 3;
        unsigned short e[8];
#pragma unroll
        for (int jj = 0; jj < 8; ++jj) { const int row = PERMK ? (32 * s + 16 * (jj >> 2) + 4 * q + (jj & 3)) : (32 * s + 8 * q + jj); e[jj] = *(const LAS unsigned short*)(raw + row * TP + c * 2); }
        u32x4 w; w.x = e[0] | ((unsigned)e[1] << 16); w.y = e[2] | ((unsigned)e[3] << 16); w.z = e[4] | ((unsigned)e[5] << 16); w.w = e[6] | ((unsigned)e[7] << 16);
        *(LAS u32x4*)(vt + c * TP + (32 * s + 8 * q) * 2) = w; }
}
__device__ __forceinline__ void attn_prompt_unit(const Frame& F, int idx) {
    OPAQUE_IDS(F); const int fr = lane & 15, fq = lane >> 4;
    const int gi = idx >> 8, rem = idx & 255, h = rem & 3, blk = rem >> 2, b = blk >> 5, rb = blk & 31;
    const int dsh = 2 * gi, dm = (1 << dsh) - 1, r = rb & dm, n = rb >> dsh;
    const bf16_t* Pb = F.P() + (size_t)(b * SEQ) * NIN;
    const int qcol = 1024 + gi * 1536 + h * 128, kcol = qcol + 512, vcol = qcol + 1024;
    LAS unsigned char* kbuf = F.lds + L_KBUF; LAS unsigned char* vraw = F.lds + L_VRAW; LAS unsigned char* vt = F.lds + L_VT; LAS float* bt = (LAS float*)(F.lds + L_BT);
    __syncthreads();
    if (tid < 129) bt[tid] = inp(I_RELB)[(int)BKT[gi][tid] * 12 + gi * 4 + h];
    const int iq = 16 * wave + fr;
    const size_t qpos = ((size_t)(128 * n + iq) << dsh) + r;
    bf16x8 qf[4];
#pragma unroll
    for (int s = 0; s < 4; ++s) qf[s] = *(const bf16x8*)(Pb + qpos * NIN + qcol + 32 * s + 8 * fq);
    f32x4 S[16];
#pragma unroll
    for (int t = 0; t < 16; ++t) S[t] = (f32x4){0.f, 0.f, 0.f, 0.f};
    const int hf0 = (n == 0) ? 1 : 0;
#pragma unroll
    for (int hf = 0; hf < 2; ++hf) {
        if (hf >= hf0) {
#pragma unroll
            for (int i = 0; i < 4; ++i) { const int c = tid + NTHREADS * i, row = c >> 4, ch = c & 15; const size_t pk = ((size_t)(128 * (n - 1 + hf) + row) << dsh) + r;
                *(LAS u32x4*)(kbuf + row * TP + ch * 16) = *(const u32x4*)(Pb + pk * NIN + kcol + ch * 8); }
            __syncthreads();
#pragma unroll
            for (int t = 0; t < 8; ++t)
#pragma unroll
                for (int s = 0; s < 4; ++s) { const bf16x8 kf = *(const LAS bf16x8*)(kbuf + (16 * t + fr) * TP + 64 * s + 16 * fq);
                    S[hf * 8 + t] = __builtin_amdgcn_mfma_f32_16x16x32_bf16(kf, qf[s], S[hf * 8 + t], 0, 0, 0); if (s == 3 && (t & 1)) __builtin_amdgcn_sched_barrier(0); }
            __syncthreads();
        }
    }
    float mx = -3.0e38f;
#pragma unroll
    for (int T = 0; T < 16; ++T)
#pragma unroll
        for (int j = 0; j < 4; ++j) { const int jb = 16 * T + 4 * fq + j, diff = 128 + iq - jb; const bool valid = (diff >= 0) && (diff <= 128) && (jb >= 128 * hf0);
            const float lg = valid ? S[T][j] * ATT_SCALE + bt[valid ? diff : 0] : -1.0e30f; S[T][j] = lg; mx = fmaxf(mx, lg); if (j == 3) __builtin_amdgcn_sched_barrier(0); }
    mx = fmaxf(mx, __shfl_xor(mx, 16)); mx = fmaxf(mx, __shfl_xor(mx, 32));
    float sum = 0.f;
#pragma unroll
    for (int T = 0; T < 16; ++T)
#pragma unroll
        for (int j = 0; j < 4; ++j) { const float p = S[T][j] > -1.0e29f ? __expf(S[T][j] - mx) : 0.f; S[T][j] = p; sum += p; if (j == 3) __builtin_amdgcn_sched_barrier(0); }
    sum += __shfl_xor(sum, 16); sum += __shfl_xor(sum, 32);
    const float inv = 1.0f / sum, lse = mx + __logf(sum);
    bf16x8 pf[8];
#pragma unroll
    for (int ks = 0; ks < 8; ++ks) { const f32x4 a = S[2 * ks] * inv, c = S[2 * ks + 1] * inv;
        u32x4 w; w.x = cvt_pk_bf16(a[0], a[1]); w.y = cvt_pk_bf16(a[2], a[3]); w.z = cvt_pk_bf16(c[0], c[1]); w.w = cvt_pk_bf16(c[2], c[3]); pf[ks] = __builtin_bit_cast(bf16x8, w); }
    f32x4 O[8];
#pragma unroll
    for (int et = 0; et < 8; ++et) O[et] = (f32x4){0.f, 0.f, 0.f, 0.f};
#pragma unroll
    for (int hf = 0; hf < 2; ++hf) {
        if (hf >= hf0) {
#pragma unroll
            for (int i = 0; i < 4; ++i) { const int c = tid + NTHREADS * i, row = c >> 4, ch = c & 15; const size_t pk = ((size_t)(128 * (n - 1 + hf) + row) << dsh) + r;
                *(LAS u32x4*)(vraw + row * TP + ch * 16) = *(const u32x4*)(Pb + pk * NIN + vcol + ch * 8); }
            __syncthreads();
            lds_transpose<true>(vraw, vt, tid);
            __syncthreads();
#pragma unroll
            for (int s = 0; s < 4; ++s)
#pragma unroll
                for (int et = 0; et < 8; ++et) { const bf16x8 vf = *(const LAS bf16x8*)(vt + (16 * et + fr) * TP + 64 * s + 16 * fq);
                    O[et] = __builtin_amdgcn_mfma_f32_16x16x32_bf16(vf, pf[hf * 4 + s], O[et], 0, 0, 0); if (et == 7) __builtin_amdgcn_sched_barrier(0); }
        }
    }
    const size_t orow = (size_t)gi * MP + (size_t)b * SEQ + qpos;
    bf16_t* op = F.OG() + orow * BRW + h * 128 + 4 * fq;
#pragma unroll
    for (int et = 0; et < 8; ++et) { u32x2 w; w.x = cvt_pk_bf16(O[et][0], O[et][1]); w.y = cvt_pk_bf16(O[et][2], O[et][3]); *(u32x2*)(op + 16 * et) = w; }
    if (fq == 0) F.LSE()[orow * 4 + h] = lse;
}
__device__ __forceinline__ void gmlp_prompt_unit(const Frame& F, int l, int idx) {
    OPAQUE_IDS(F); const int fr = lane & 15, fq = lane >> 4;
    const int g = idx & 3, chunk = idx >> 2; const size_t row0 = (size_t)chunk * 128;
    LAS unsigned char* vraw = F.lds + L_VRAW; LAS unsigned char* vt = F.lds + L_VT;
    __syncthreads();
    {
        const int myg = lane >> 4, cl = (lane & 15) * 8; const float* alng = inp(I_ALNG); const float* alnb = inp(I_ALNB);
        float lg[8], lb[8];
#pragma unroll
        for (int i = 0; i < 8; ++i) { lg[i] = alng[l * BRW + myg * 128 + cl + i]; lb[i] = alnb[l * BRW + myg * 128 + cl + i]; }
#pragma unroll 4
        for (int rr = 0; rr < 16; ++rr) { const int j = 16 * wave + rr;
            const u32x4 raw = *(const u32x4*)(F.P() + (row0 + j) * NIN + 512 + lane * 8);
            float x[8]; unpack8(raw, x);
            float s = 0.f;
#pragma unroll
            for (int i = 0; i < 8; ++i) s += x[i];
            const float mean = wave_sum(s) * (1.0f / BRW); float q = 0.f;
#pragma unroll
            for (int i = 0; i < 8; ++i) { x[i] -= mean; q += x[i] * x[i]; }
            const float rstd = 1.0f / sqrtf(wave_sum(q) * (1.0f / BRW) + LN_EPS);
            if (myg == g) { float y[8];
#pragma unroll
                for (int i = 0; i < 8; ++i) y[i] = x[i] * rstd * lg[i] + lb[i];
                *(LAS u32x4*)(vraw + j * TP + (lane & 15) * 16) = pack8(y); }
        }
    }
    __syncthreads();
    lds_transpose<false>(vraw, vt, tid);
    __syncthreads();
    const int i_row = 16 * wave + fr; const float* aws = inp(I_AWS);
    f32x4 acc[8];
#pragma unroll
    for (int ct = 0; ct < 8; ++ct) acc[ct] = (f32x4){0.f, 0.f, 0.f, 0.f};
#pragma unroll
    for (int s = 0; s < 4; ++s) {
        if (32 * s <= 16 * wave + 15) {
            const float* wsp = aws + ((size_t)((l * 4 + g) * 128 + i_row)) * 128 + 32 * s + 8 * fq;
            const f32x4 w0 = *(const f32x4*)wsp, w1 = *(const f32x4*)(wsp + 4);
            float wv[8] = {w0[0], w0[1], w0[2], w0[3], w1[0], w1[1], w1[2], w1[3]};
#pragma unroll
            for (int jj = 0; jj < 8; ++jj) wv[jj] = (32 * s + 8 * fq + jj <= i_row) ? wv[jj] : 0.f;
            const bf16x8 wf = __builtin_bit_cast(bf16x8, pack8(wv));
#pragma unroll
            for (int ct = 0; ct < 8; ++ct) { const bf16x8 vf = *(const LAS bf16x8*)(vt + (16 * ct + fr) * TP + 64 * s + 16 * fq);
                acc[ct] = __builtin_amdgcn_mfma_f32_16x16x32_bf16(vf, wf, acc[ct], 0, 0, 0); }
        }
    }
    const float bsv = inp(I_ABS)[(l * 4 + g) * 128 + i_row];
#pragma unroll
    for (int ct = 0; ct < 8; ++ct) { const int c0 = g * 128 + 16 * ct + 4 * fq;
        const u32x2 uw = *(const u32x2*)(F.P() + (row0 + i_row) * NIN + c0);
        const float y0 = bflo(uw.x) * (acc[ct][0] + bsv), y1 = bfhi(uw.x) * (acc[ct][1] + bsv), y2 = bflo(uw.y) * (acc[ct][2] + bsv), y3 = bfhi(uw.y) * (acc[ct][3] + bsv);
        u32x2 w; w.x = cvt_pk_bf16(y0, y1); w.y = cvt_pk_bf16(y2, y3); *(u32x2*)(F.YS() + (row0 + i_row) * D + c0) = w; }
}
__device__ __forceinline__ void pool_prompt_unit(const Frame& F, int l, int idx) {
    OPAQUE_IDS(F); const int fr = lane & 15, fq = lane >> 4;
    const int gi = idx & 3, tile = idx >> 2, win = 2 << gi;
    const int t = ((tile & 31) << 7) + 16 * wave + fr;
    const size_t row = (size_t)tile * 128 + 16 * wave + fr;
    const float icnt = 1.0f / (float)((t + 1) < win ? (t + 1) : win);
    f32x4 acc[8];
#pragma unroll
    for (int dt = 0; dt < 8; ++dt) acc[dt] = (f32x4){0.f, 0.f, 0.f, 0.f};
    const bf16_t* pw = F.POOLWT() + ((size_t)(l * 4 + gi)) * 128 * 128; const float* poolb = inp(I_POOLB); const float* pools = inp(I_POOLS);
#pragma unroll
    for (int s = 0; s < 4; ++s) {
        const bf16_t* pc = F.P() + row * NIN + 5632 + gi * 128 + 32 * s + 8 * fq;
        float sum[8], cur[8];
        unpack8(*(const u32x4*)pc, cur);
#pragma unroll
        for (int i = 0; i < 8; ++i) sum[i] = cur[i];
        for (int k = 1; k < win; ++k) { if (t - k >= 0) { float v[8]; unpack8(*(const u32x4*)(pc - (size_t)k * NIN), v);
#pragma unroll
                for (int i = 0; i < 8; ++i) sum[i] += v[i]; } }
        float pl[8];
#pragma unroll
        for (int i = 0; i < 8; ++i) pl[i] = sum[i] * icnt - cur[i];
        const bf16x8 bfrag = __builtin_bit_cast(bf16x8, pack8(pl));
#pragma unroll
        for (int dt = 0; dt < 8; ++dt) { const bf16x8 af = *(const bf16x8*)(pw + (size_t)(16 * dt + fr) * 128 + 32 * s + 8 * fq);
            acc[dt] = __builtin_amdgcn_mfma_f32_16x16x32_bf16(af, bfrag, acc[dt], 0, 0, 0); }
        __builtin_amdgcn_sched_barrier(0);
    }
#pragma unroll
    for (int dt = 0; dt < 8; ++dt) { const int ch = gi * 128 + 16 * dt + 4 * fq;
        const f32x4 pb = *(const f32x4*)(poolb + l * BRW + ch), ps = *(const f32x4*)(pools + l * BRW + ch);
        const f32x4 y = (acc[dt] + pb) * ps;
        u32x2 w; w.x = cvt_pk_bf16(y[0], y[1]); w.y = cvt_pk_bf16(y[2], y[3]); *(u32x2*)(F.YS() + row * D + 1024 + ch) = w; }
}
__device__ __forceinline__ void conv_prompt_unit(const Frame& F, int l, int idx) {
    OPAQUE_IDS(F);
    const int b = idx >> 5, t0 = ((idx & 31) << 7) + 16 * wave;
    const size_t rowb = (size_t)b * SEQ;
    float w0[8], w1[8], w2[8];
    { const float* cw = inp(I_CONVW) + ((size_t)l * BRW + 8 * lane) * 3; float t[24];
#pragma unroll
        for (int i = 0; i < 6; ++i) { const f32x4 v = *(const f32x4*)(cw + 4 * i); t[4 * i] = v[0]; t[4 * i + 1] = v[1]; t[4 * i + 2] = v[2]; t[4 * i + 3] = v[3]; }
#pragma unroll
        for (int i = 0; i < 8; ++i) { w0[i] = t[3 * i]; w1[i] = t[3 * i + 1]; w2[i] = t[3 * i + 2]; } }
    float z2[8], z1[8];
#pragma unroll
    for (int i = 0; i < 8; ++i) { z2[i] = 0.f; z1[i] = 0.f; }
    for (int tt = t0 - 2; tt < t0 + 16; ++tt) {
        if (tt < 0) continue;
        const bf16_t* pr = F.P() + (rowb + tt) * NIN + 6144 + 8 * lane;
        float cg[8], hs[8], z[8]; unpack8(*(const u32x4*)(pr + 512), cg); unpack8(*(const u32x4*)(pr + 1024), hs);
#pragma unroll
        for (int i = 0; i < 8; ++i) z[i] = cg[i] * hs[i];
        if (tt >= t0) {
            float bg[8], y[8]; unpack8(*(const u32x4*)pr, bg);
#pragma unroll
            for (int i = 0; i < 8; ++i) y[i] = bg[i] * (z2[i] * w0[i] + z1[i] * w1[i] + z[i] * w2[i]);
            *(u32x4*)(F.YS() + (rowb + tt) * D + 1536 + 8 * lane) = pack8(y);
            if (tt >= SEQ - 2) { float* o = F.out + OUT_CONVP + ((size_t)((l * NBP + b) * 2 + (tt - (SEQ - 2)))) * BRW + 8 * lane;
                *(f32x4*)o = (f32x4){z[0], z[1], z[2], z[3]}; *(f32x4*)(o + 4) = (f32x4){z[4], z[5], z[6], z[7]}; }
        }
#pragma unroll
        for (int i = 0; i < 8; ++i) { z2[i] = z1[i]; z1[i] = z[i]; }
    }
}
__device__ __forceinline__ void attn_sample_unit(const Frame& F, int l, int idx) {
    OPAQUE_IDS(F);
    const int h = idx & 3, t = (idx >> 2) & 3, b = idx >> 4;
    LAS float* qs = (LAS float*)F.lds;
    LAS float* ps = qs + 384;
    LAS float* os = ps + 396;
    LAS float* ls = os + 384;
    const size_t prow = (size_t)(MP + b * TS + t);
    __syncthreads();
    if (wave < 3) {
        const int gi = wave, dsh = 2 * gi, wb = 128 << dsh;
        const int qcol = 1024 + gi * 1536 + h * 128, kcol = qcol + 512, vcol = qcol + 1024;
        { const unsigned qw = *(const unsigned*)(F.P() + prow * NIN + qcol + 2 * lane); qs[gi * 128 + 2 * lane] = bflo(qw); qs[gi * 128 + 2 * lane + 1] = bfhi(qw); }
        { float* ob = F.out + (gi == 0 ? OUT_B1S : (gi == 1 ? OUT_B2S : OUT_B3S)) + ((size_t)((l * NBS + b) * TS + t)) * 1024 + h * 128 + 2 * lane;
            const unsigned kw = *(const unsigned*)(F.P() + prow * NIN + kcol + 2 * lane), vw = *(const unsigned*)(F.P() + prow * NIN + vcol + 2 * lane);
            *(f32x2*)ob = (f32x2){bflo(kw), bfhi(kw)}; *(f32x2*)(ob + 512) = (f32x2){bflo(vw), bfhi(vw)}; }
        asm volatile("s_waitcnt lgkmcnt(0)" ::: "memory");
        const float* relb = inp(I_RELB);
        const float* cache = inp(I_CB1 + gi) + ((size_t)(l * NBS + b) * wb) * 1024;
        float lg[3]; float mx = -3.0e38f;
#pragma unroll
        for (int k3 = 0; k3 < 3; ++k3) { const int st = lane + 64 * k3; lg[k3] = -3.0e38f;
            if (st <= 128) { const int kidx = wb + t - (st << dsh); float dot = 0.f;
                if (kidx < wb) { const float* kp = cache + (size_t)kidx * 1024 + h * 128;
#pragma unroll 8
                    for (int e = 0; e < 128; e += 4) { const f32x4 kv = *(const f32x4*)(kp + e); const f32x4 qv = *(const LAS f32x4*)(qs + gi * 128 + e); dot += (kv[0] * qv[0] + kv[1] * qv[1]) + (kv[2] * qv[2] + kv[3] * qv[3]); } }
                else { const bf16_t* kp = F.P() + (size_t)(MP + b * TS + (kidx - wb)) * NIN + kcol;
#pragma unroll 4
                    for (int e = 0; e < 128; e += 8) { float kv[8]; unpack8(*(const u32x4*)(kp + e), kv);
#pragma unroll
                        for (int i = 0; i < 8; ++i) dot += kv[i] * qs[gi * 128 + e + i]; } }
                lg[k3] = dot * ATT_SCALE + relb[(int)BKT[gi][st] * 12 + gi * 4 + h]; mx = fmaxf(mx, lg[k3]); } }
        mx = wave_max(mx);
        float sum = 0.f;
#pragma unroll
        for (int k3 = 0; k3 < 3; ++k3) { const int st = lane + 64 * k3; if (st <= 128) { lg[k3] = __expf(lg[k3] - mx); sum += lg[k3]; } }
        sum = wave_sum(sum);
        const float inv = 1.0f / sum;
#pragma unroll
        for (int k3 = 0; k3 < 3; ++k3) { const int st = lane + 64 * k3; if (st <= 128) ps[gi * 132 + st] = lg[k3] * inv; }
        asm volatile("s_waitcnt lgkmcnt(0)" ::: "memory");
        float o0 = 0.f, o1 = 0.f;
        for (int st = 0; st <= 128; ++st) { const int kidx = wb + t - (st << dsh); const float p = ps[gi * 132 + st];
            if (kidx < wb) { const f32x2 v = *(const f32x2*)(cache + (size_t)kidx * 1024 + 512 + h * 128 + 2 * lane); o0 += p * v[0]; o1 += p * v[1]; }
            else { const unsigned vw = *(const unsigned*)(F.P() + (size_t)(MP + b * TS + (kidx - wb)) * NIN + vcol + 2 * lane); o0 += p * bflo(vw); o1 += p * bfhi(vw); } }
        os[gi * 128 + 2 * lane] = o0; os[gi * 128 + 2 * lane + 1] = o1;
        if (lane == 0) ls[gi] = mx + __logf(sum);
    }
    __syncthreads();
    if (tid < 128) { const float l0 = ls[0], l1 = ls[1], l2 = ls[2], m = fmaxf(l0, fmaxf(l1, l2)); const float e0 = __expf(l0 - m), e1 = __expf(l1 - m), e2 = __expf(l2 - m), inv = 1.0f / (e0 + e1 + e2);
        const float y = (e0 * os[tid] + e1 * os[128 + tid] + e2 * os[256 + tid]) * inv;
        F.YS()[prow * D + 512 + h * 128 + tid] = (bf16_t)f2bf(y); }
}
__device__ __forceinline__ void misc_sample_unit(const Frame& F, int l, int b) {
    OPAQUE_IDS(F);
    LAS float* red = (LAS float*)F.lds;
    LAS float* pl = red + 64;
    const size_t prow = (size_t)(MP + b * TS);
    __syncthreads();
    float vx[4], s4[4];
#pragma unroll
    for (int j = 0; j < 4; ++j) { vx[j] = bf1(F.P()[(prow + j) * NIN + 512 + tid]); s4[j] = wave_sum(vx[j]); }
    if (lane == 0) {
#pragma unroll
        for (int j = 0; j < 4; ++j) red[wave * 4 + j] = s4[j]; }
    __syncthreads();
    float mean[4];
#pragma unroll
    for (int j = 0; j < 4; ++j) { float s = 0.f;
#pragma unroll
        for (int w = 0; w < 8; ++w) s += red[w * 4 + j];
        mean[j] = s * (1.0f / BRW); vx[j] -= mean[j]; }
    __syncthreads();
#pragma unroll
    for (int j = 0; j < 4; ++j) s4[j] = wave_sum(vx[j] * vx[j]);
    if (lane == 0) {
#pragma unroll
        for (int j = 0; j < 4; ++j) red[wave * 4 + j] = s4[j]; }
    __syncthreads();
    const float lng = inp(I_ALNG)[l * BRW + tid], lnb = inp(I_ALNB)[l * BRW + tid];
    float v[4];
#pragma unroll
    for (int j = 0; j < 4; ++j) { float s = 0.f;
#pragma unroll
        for (int w = 0; w < 8; ++w) s += red[w * 4 + j];
        v[j] = vx[j] / sqrtf(s * (1.0f / BRW) + LN_EPS) * lng + lnb;
        F.out[OUT_CHUNKV + ((size_t)((l * NBS + b) * TS + j)) * BRW + tid] = v[j]; }
    { const int g = tid >> 7; const float* wsb = inp(I_AWS) + ((size_t)(l * 4 + g)) * 128 * 128; const float* absp = inp(I_ABS);
#pragma unroll
        for (int i = 0; i < 4; ++i) { float mix = absp[(l * 4 + g) * 128 + i];
#pragma unroll
            for (int j = 0; j < 4; ++j) if (j <= i) mix += wsb[i * 128 + j] * v[j];
            const float u = bf1(F.P()[(prow + i) * NIN + tid]);
            F.YS()[(prow + i) * D + tid] = (bf16_t)f2bf(u * mix); } }
    { const int gi = tid >> 7, win = 2 << gi; float full[19]; const float* cpool = inp(I_CPOOL);
#pragma unroll
        for (int k = 0; k < 15; ++k) full[k] = cpool[((size_t)((l * NBS + b) * 15 + k)) * BRW + tid];
#pragma unroll
        for (int j = 0; j < 4; ++j) { full[15 + j] = bf1(F.P()[(prow + j) * NIN + 5632 + tid]); F.out[OUT_POOLS + ((size_t)((l * NBS + b) * TS + j)) * BRW + tid] = full[15 + j]; }
#pragma unroll
        for (int j = 0; j < 4; ++j) { float s = 0.f;
#pragma unroll
            for (int k = 0; k < 16; ++k) if (k < win) s += full[15 + j - k];
            pl[j * BRW + tid] = s / (float)win - full[15 + j]; } }
    __syncthreads();
    { const int g = tid >> 7, d = tid & 127; const float* pw = inp(I_POOLW) + ((size_t)(l * 4 + g)) * 128 * 128 + d;
        float y[4] = {0.f, 0.f, 0.f, 0.f};
#pragma unroll 8
        for (int c = 0; c < 128; ++c) { const float w = pw[c * 128];
#pragma unroll
            for (int j = 0; j < 4; ++j) y[j] += pl[j * BRW + g * 128 + c] * w; }
        const float pb = inp(I_POOLB)[l * BRW + tid], psc = inp(I_POOLS)[l * BRW + tid];
#pragma unroll
        for (int j = 0; j < 4; ++j) F.YS()[(prow + j) * D + 1024 + tid] = (bf16_t)f2bf((y[j] + pb) * psc); }
    { const float* cvw = inp(I_CONVW) + ((size_t)l * BRW + tid) * 3; const float* ccv = inp(I_CCONV) + ((size_t)(l * NBS + b) * 2) * BRW + tid; const float w0 = cvw[0], w1 = cvw[1], w2 = cvw[2];
        float z2 = ccv[0], z1 = ccv[BRW];
#pragma unroll
        for (int j = 0; j < 4; ++j) { const bf16_t* pr = F.P() + (prow + j) * NIN + 6144 + tid; const float z = bf1(pr[512]) * bf1(pr[1024]);
            const float y = bf1(pr[0]) * (z2 * w0 + z1 * w1 + z * w2);
            F.YS()[(prow + j) * D + 1536 + tid] = (bf16_t)f2bf(y); F.out[OUT_CONVS + ((size_t)((l * NBS + b) * TS + j)) * BRW + tid] = z; z2 = z1; z1 = z; } }
}
constexpr int MX_SATT = 0, MX_SMISC = 128, MX_ATT = 136, MX_GMLP = 904, MX_POOL = 1160, MX_CONV = 1416, MX_END = 1480;
#ifndef UNIT_MASK
#define UNIT_MASK 0xFF
#endif
#define UON(k) (((UNIT_MASK) >> (k)) & 1)
__device__ __forceinline__ void mixer_phase(const Frame& F, int l) {
    for (int u = F.vcu; u < MX_END; u += F.G) {
        if (u < MX_SMISC) { if (UON(0)) attn_sample_unit(F, l, u); }
        else if (u < MX_ATT) { if (UON(1)) misc_sample_unit(F, l, u - MX_SMISC); }
        else if (u < MX_GMLP) { if (UON(2)) attn_prompt_unit(F, u - MX_ATT); }
        else if (u < MX_POOL) { if (UON(3)) gmlp_prompt_unit(F, l, u - MX_GMLP); }
        else if (u < MX_CONV) { if (UON(4)) pool_prompt_unit(F, l, u - MX_POOL); }
        else { if (UON(5)) conv_prompt_unit(F, l, u - MX_CONV); }
    }
}
__device__ __forceinline__ void combine_phase(const Frame& F, int l) {
    OPAQUE_IDS(F);
    const int gw = F.vcu * NWAVES + wave, NGW = F.G * NWAVES;
    for (int row = gw; row < MP; row += NGW) {
        const int h = lane >> 4;
        const float l0 = F.LSE()[((size_t)0 * MP + row) * 4 + h], l1 = F.LSE()[((size_t)1 * MP + row) * 4 + h], l2 = F.LSE()[((size_t)2 * MP + row) * 4 + h];
        const float m = fmaxf(l0, fmaxf(l1, l2)), e0 = __expf(l0 - m), e1 = __expf(l1 - m), e2 = __expf(l2 - m), inv = 1.0f / (e0 + e1 + e2);
        float a[8], c[8], y[8];
        unpack8(*(const u32x4*)(F.OG() + ((size_t)0 * MP + row) * BRW + 8 * lane), a);
#pragma unroll
        for (int i = 0; i < 8; ++i) y[i] = e0 * a[i];
        unpack8(*(const u32x4*)(F.OG() + ((size_t)1 * MP + row) * BRW + 8 * lane), c);
#pragma unroll
        for (int i = 0; i < 8; ++i) y[i] += e1 * c[i];
        unpack8(*(const u32x4*)(F.OG() + ((size_t)2 * MP + row) * BRW + 8 * lane), a);
#pragma unroll
        for (int i = 0; i < 8; ++i) y[i] = (y[i] + e2 * a[i]) * inv;
        *(u32x4*)(F.YS() + (size_t)row * D + 512 + 8 * lane) = pack8(y);
    }
    constexpr int NR = NBP * (128 + 512 + 2048);
    for (int it = gw; it < NR; it += NGW) {
        int gi, rem;
        if (it < NBP * 128) { gi = 0; rem = it; } else if (it < NBP * (128 + 512)) { gi = 1; rem = it - NBP * 128; } else { gi = 2; rem = it - NBP * (128 + 512); }
        const int keep = 128 << (2 * gi), b = rem / keep, rr = rem % keep;
        const bf16_t* src = F.P() + ((size_t)b * SEQ + SEQ - keep + rr) * NIN + 1024 + gi * 1536 + 512 + 16 * lane;
        float* dst = F.out + (gi == 0 ? OUT_B1P : (gi == 1 ? OUT_B2P : OUT_B3P)) + ((size_t)((l * NBP + b) * keep + rr)) * 1024 + 16 * lane;
        float a[8], c[8]; unpack8(*(const u32x4*)src, a); unpack8(*(const u32x4*)(src + 8), c);
        *(f32x4*)dst = (f32x4){a[0], a[1], a[2], a[3]}; *(f32x4*)(dst + 4) = (f32x4){a[4], a[5], a[6], a[7]};
        *(f32x4*)(dst + 8) = (f32x4){c[0], c[1], c[2], c[3]}; *(f32x4*)(dst + 12) = (f32x4){c[4], c[5], c[6], c[7]};
    }
    for (int it = gw; it < NBP * 15; it += NGW) { const int b = it / 15, rr = it % 15;
        float a[8]; unpack8(*(const u32x4*)(F.P() + ((size_t)b * SEQ + SEQ - 15 + rr) * NIN + 5632 + 8 * lane), a);
        float* dst = F.out + OUT_POOLP + ((size_t)((l * NBP + b) * 15 + rr)) * BRW + 8 * lane;
        *(f32x4*)dst = (f32x4){a[0], a[1], a[2], a[3]}; *(f32x4*)(dst + 4) = (f32x4){a[4], a[5], a[6], a[7]}; }
}

struct Args { const float* in[31]; float* out; unsigned char* ws; int ph_lo, ph_hi; };
constexpr int PH_PER_LAYER = 9, PH_FINAL = 2 + DEPTH * PH_PER_LAYER, N_PHASES = PH_FINAL + 1;

__global__ void __launch_bounds__(NTHREADS, 2) fwd_kernel(Args args) {
    extern __shared__ __attribute__((aligned(16))) unsigned char lds_raw[];
    Frame F;
    F.lds = (LAS unsigned char*)lds_raw;
    F.tid = threadIdx.x; F.lane = F.tid & 63; F.wave = __builtin_amdgcn_readfirstlane(F.tid >> 6);
    F.G = gridDim.x; { const int bx = blockIdx.x; F.vcu = (F.G % 8 == 0) ? (bx % 8) * (F.G / 8) + bx / 8 : bx; }
    F.out = args.out; F.ws = args.ws;
    unsigned char* ws = args.ws;

    volatile LAS unsigned* MISC = (volatile LAS unsigned*)(F.lds + MISC_OFF);
    for (int u = F.tid; u < (LDS_BYTES - LDSCTL_OFF) / 4; u += NTHREADS) ((LAS unsigned*)(F.lds + LDSCTL_OFF))[u] = 0u;
    __syncthreads();
    const int lo = args.ph_lo, hi = args.ph_hi;
    XcdBarrier bar; bar.bar = (unsigned*)(ws + WS_CTL) + CW_BAR; bar.x = 0; bar.st = nullptr;
    if (hi - lo > 1) bar = xcd_barrier_post((unsigned*)(ws + WS_CTL) + CW_BAR, MISC + 8);
#ifndef PHASE_MASK
#define PHASE_MASK 0xFFFF
#endif
#define ON(kind) (((PHASE_MASK) >> (kind)) & 1)
#define IN(k) (lo <= (k) && (k) < hi)
#define SEAM(k) do { if (IN(k) && IN((k) + 1)) xcd_barrier(bar); } while (0)

    if (ON(0) && IN(0)) { p0a_phase(F); } SEAM(0);
    if (ON(1) && IN(1)) { p0b_phase(F); } SEAM(1);
    for (int l = 0; l < DEPTH; ++l) {
        const int pb = 2 + l * PH_PER_LAYER;
        const float* modl = F.MOD() + (size_t)l * NBB * 6 * D;
        if (ON(2) && IN(pb + 0)) { norm_phase(F, modl, 1, 0); } SEAM(pb + 0);
        if (ON(3) && IN(pb + 1)) {
            pg8::Gemm g{F.HN(), (const bf16_t*)(ws + WS_BT1 + l * BT1_L), D, D, D}; pg8::StaticOrder S; S.init(MPAD / 256, N1 / 256, F.G, (int)blockIdx.x, D, D);
            pg8::Epi1 E{F.P(), F.GATES(), inp(I_BGATE) + (size_t)l * NGATE};
            pg8::gemm_phase<pg8::Epi1, pg8::StaticOrder>(F.lds, g, S, E);
        } SEAM(pb + 1);
        if (ON(4) && IN(pb + 2)) { mixer_phase(F, l); } SEAM(pb + 2);
        if (ON(5) && IN(pb + 3)) { combine_phase(F, l); } SEAM(pb + 3);
        if (ON(6) && IN(pb + 4)) {
            pg8::Gemm g{F.YS(), (const bf16_t*)(ws + WS_BT2 + l * BT2_L), D, BRW, BRW}; pg8::BranchOrder S{F.G, F.vcu, (MPAD / 256) * (D / 256)};
            pg8::Epi2 E{F.GATES(), F.MERGED(), F.ACC() + (size_t)F.vcu * (32 * 512 * 4)};
            pg8::gemm_phase<pg8::Epi2, pg8::BranchOrder>(F.lds, g, S, E);
        } SEAM(pb + 4);
        if (ON(7) && IN(pb + 5)) {
            pg8::Gemm g{F.MERGED(), (const bf16_t*)(ws + WS_BT3 + l * BT3_L), D, D, D}; pg8::StaticOrder S; S.init(MPAD / 256, D / 256, F.G, (int)blockIdx.x, D, D);
            pg8::EpiRes E{F.X(), modl, 2};
            pg8::gemm_phase<pg8::EpiRes, pg8::StaticOrder>(F.lds, g, S, E);
        } SEAM(pb + 5);
        if (ON(8) && IN(pb + 6)) { norm_phase(F, modl, 4, 3); } SEAM(pb + 6);
        if (ON(9) && IN(pb + 7)) {
            pg8::Gemm g{F.HN(), (const bf16_t*)(ws + WS_BT4 + l * BT4_L), D, D, D}; pg8::StaticOrder S; S.init(MPAD / 256, N4 / 256, F.G, (int)blockIdx.x, D, D);
            pg8::EpiSwi E{F.H()};
            pg8::gemm_phase<pg8::EpiSwi, pg8::StaticOrder>(F.lds, g, S, E);
        } SEAM(pb + 7);
        if (ON(10) && IN(pb + 8)) {
            pg8::Gemm g{F.H(), (const bf16_t*)(ws + WS_BT5 + l * BT5_L), DFF, DFF, DFF}; pg8::StaticOrder S; S.init(MPAD / 256, D / 256, F.G, (int)blockIdx.x, DFF, DFF);
            pg8::EpiRes E{F.X(), modl, 5};
            pg8::gemm_phase<pg8::EpiRes, pg8::StaticOrder>(F.lds, g, S, E);
        } SEAM(pb + 8);
    }
    if (ON(11) && IN(PH_FINAL)) { final_norm_phase(F); }
#undef IN
#undef SEAM
}

extern "C" void kernel_launch(void* const* d_in, const int* in_sizes, int n_in, void* d_out, int out_size, void* d_ws, size_t ws_size, hipStream_t stream) {
    static int grid = 0;
    if (grid == 0) {
        if (n_in != 31 || (size_t)out_size != OUT_END || ws_size < WS_END) { fprintf(stderr, "kernel_launch: unexpected problem (n_in %d, out %d, ws %zu)\n", n_in, out_size, ws_size); grid = -1; return; }
        int dev = 0, cus = 0, per_cu = 0;
        if (hipGetDevice(&dev) != hipSuccess || hipDeviceGetAttribute(&cus, hipDeviceAttributeMultiprocessorCount, dev) != hipSuccess) { grid = -1; return; }
        if (hipFuncSetAttribute((const void*)fwd_kernel, hipFuncAttributeMaxDynamicSharedMemorySize, LDS_BYTES) != hipSuccess) { fprintf(stderr, "kernel_launch: hipFuncSetAttribute failed\n"); grid = -1; return; }
        if (hipOccupancyMaxActiveBlocksPerMultiprocessor(&per_cu, (const void*)fwd_kernel, NTHREADS, LDS_BYTES) != hipSuccess || per_cu < 1) fprintf(stderr, "kernel_launch: occupancy query reports %d\n", per_cu);
        (void)hipGetLastError();
        grid = cus < 256 ? cus : 256;
    }
    if (grid < 0) return;
    if (hipMemsetAsync((char*)d_ws + WS_CTL, 0, CTL_ZERO_BYTES, stream) != hipSuccess) return;
    Args a{};
    for (int i = 0; i < 31; ++i) a.in[i] = (const float*)d_in[i];
    a.out = (float*)d_out; a.ws = (unsigned char*)d_ws;
#if MK_MULTI_LAUNCH
    for (int ph = 0; ph < N_PHASES; ++ph) { a.ph_lo = ph; a.ph_hi = ph + 1; hipLaunchKernelGGL(fwd_kernel, dim3(grid), dim3(NTHREADS), LDS_BYTES, stream, a); }
#else
    a.ph_lo = 0; a.ph_hi = N_PHASES; hipLaunchKernelGGL(fwd_kernel, dim3(grid), dim3(NTHREADS), LDS_BYTES, stream, a);
#endif
}
```

```cpp
#include <hip/hip_runtime.h>
#include <cstdio>
#include <cstdint>

#ifndef MK_MULTI_LAUNCH
#define MK_MULTI_LAUNCH 0
#endif

#define LAS __attribute__((address_space(3)))
#define GAS __attribute__((address_space(1)))
typedef unsigned short bf16_t;
typedef short bf16x8 __attribute__((ext_vector_type(8)));
typedef float f32x4 __attribute__((ext_vector_type(4)));
typedef float f32x2 __attribute__((ext_vector_type(2)));
typedef unsigned u32x4 __attribute__((ext_vector_type(4)));
typedef unsigned u32x2 __attribute__((ext_vector_type(2)));

constexpr int D = 2048, SEQ = 4096, NBP = 2, MP = NBP * SEQ, NBS = 8, TS = 4, MS = NBS * TS, MREAL = MP + MS, MPAD = 8448;
constexpr int NIN = 7680, NGATE = 8192, N1 = NIN + NGATE, DFF = 5632, N4 = 2 * DFF, BRW = 512, DEPTH = 4, NBB = NBP + NBS;
constexpr int NWAVES = 8, NTHREADS = 512;
constexpr float RMS_EPS = 1e-6f, LN_EPS = 1e-5f;
constexpr float ATT_SCALE = 0.08838834764831845f;

constexpr size_t OUT_Y = 0;
constexpr size_t OUT_B1P = (size_t)MREAL * D;
constexpr size_t OUT_B2P = OUT_B1P + (size_t)DEPTH * NBP * 128 * 1024;
constexpr size_t OUT_B3P = OUT_B2P + (size_t)DEPTH * NBP * 512 * 1024;
constexpr size_t OUT_POOLP = OUT_B3P + (size_t)DEPTH * NBP * 2048 * 1024;
constexpr size_t OUT_CONVP = OUT_POOLP + (size_t)DEPTH * NBP * 15 * 512;
constexpr size_t OUT_B1S = OUT_CONVP + (size_t)DEPTH * NBP * 2 * 512;
constexpr size_t OUT_B2S = OUT_B1S + (size_t)DEPTH * NBS * TS * 1024;
constexpr size_t OUT_B3S = OUT_B2S + (size_t)DEPTH * NBS * TS * 1024;
constexpr size_t OUT_POOLS = OUT_B3S + (size_t)DEPTH * NBS * TS * 1024;
constexpr size_t OUT_CONVS = OUT_POOLS + (size_t)DEPTH * NBS * TS * 512;
constexpr size_t OUT_CHUNKV = OUT_CONVS + (size_t)DEPTH * NBS * TS * 512;
constexpr size_t OUT_END = OUT_CHUNKV + (size_t)DEPTH * NBS * TS * 512;
static_assert(OUT_END == 39522304, "output size");

constexpr size_t MiB = 1u << 20;
constexpr size_t WS_CTL = 0, CTL_ZERO_BYTES = 1 * MiB;
constexpr size_t WS_MOD = 1 * MiB;
constexpr size_t WS_MODP = 3 * MiB;
constexpr size_t WS_POOLWT = 33 * MiB;
constexpr size_t WS_BT1 = 34 * MiB, BT1_L = (size_t)N1 * D * 2;
constexpr size_t WS_BT2 = 282 * MiB, BT2_L = (size_t)4 * D * BRW * 2;
constexpr size_t WS_BT3 = 314 * MiB, BT3_L = (size_t)D * D * 2;
constexpr size_t WS_BT4 = 346 * MiB, BT4_L = (size_t)N4 * D * 2;
constexpr size_t WS_BT5 = 522 * MiB, BT5_L = (size_t)D * DFF * 2;
constexpr size_t WS_X = 610 * MiB;
constexpr size_t WS_HN = 676 * MiB;
constexpr size_t WS_P = 709 * MiB;
constexpr size_t WS_GATES = 833 * MiB;
constexpr size_t WS_YS = 965 * MiB;
constexpr size_t WS_OG = 998 * MiB;
constexpr size_t WS_LSE = 1022 * MiB;
constexpr size_t WS_MERGED = 1023 * MiB;
constexpr size_t WS_ACC = 1056 * MiB;
constexpr size_t WS_H = 1120 * MiB;
constexpr size_t WS_END = 1211 * MiB;
static_assert(WS_BT1 + 4 * BT1_L <= WS_BT2 && WS_BT2 + 4 * BT2_L <= WS_BT3 && WS_BT3 + 4 * BT3_L <= WS_BT4 && WS_BT4 + 4 * BT4_L <= WS_BT5 && WS_BT5 + 4 * BT5_L <= WS_X, "ws map (weights)");
static_assert(WS_X + (size_t)MPAD * D * 4 <= WS_HN && WS_HN + (size_t)MPAD * D * 2 <= WS_P && WS_P + (size_t)MPAD * NIN * 2 <= WS_GATES && WS_GATES + (size_t)MPAD * NGATE * 2 <= WS_YS, "ws map (act 1)");
static_assert(WS_YS + (size_t)MPAD * D * 2 <= WS_OG && WS_OG + (size_t)3 * MP * BRW * 2 <= WS_LSE && WS_LSE + (size_t)3 * MP * 4 * 4 <= WS_MERGED && WS_MERGED + (size_t)MPAD * D * 2 <= WS_ACC, "ws map (act 2)");
static_assert(WS_ACC + (size_t)256 * 32 * 512 * 16 <= WS_H && WS_H + (size_t)MPAD * DFF * 2 <= WS_END, "ws map (act 3)");
static_assert(WS_MOD + (size_t)DEPTH * NBB * 6 * D * 4 <= WS_MODP && WS_MODP + (size_t)16 * DEPTH * NBB * 6 * D * 4 <= WS_POOLWT, "ws map (mod)");
constexpr int CW_BAR = 4096;

constexpr int RING_BYTES = 131072;
constexpr int LDSCTL_OFF = RING_BYTES, MISC_OFF = LDSCTL_OFF + 320;
constexpr int LDS_BYTES = 147456;

__device__ __forceinline__ unsigned cvt_pk_bf16(float lo, float hi) { unsigned r; asm("v_cvt_pk_bf16_f32 %0, %1, %2" : "=v"(r) : "v"(lo), "v"(hi)); return r; }
__device__ __forceinline__ float bflo(unsigned u) { return __uint_as_float(u << 16); }
__device__ __forceinline__ float bfhi(unsigned u) { return __uint_as_float(u & 0xffff0000u); }
__device__ __forceinline__ float bf1(bf16_t b) { return __uint_as_float(((unsigned)b) << 16); }
__device__ __forceinline__ void unpack8(const u32x4 w, float (&f)[8]) { f[0] = bflo(w.x); f[1] = bfhi(w.x); f[2] = bflo(w.y); f[3] = bfhi(w.y); f[4] = bflo(w.z); f[5] = bfhi(w.z); f[6] = bflo(w.w); f[7] = bfhi(w.w); }
__device__ __forceinline__ u32x4 pack8(const float (&f)[8]) { u32x4 w; w.x = cvt_pk_bf16(f[0], f[1]); w.y = cvt_pk_bf16(f[2], f[3]); w.z = cvt_pk_bf16(f[4], f[5]); w.w = cvt_pk_bf16(f[6], f[7]); return w; }
__device__ __forceinline__ float wave_sum(float v) {
#pragma unroll
    for (int o = 1; o < 64; o <<= 1) v += __shfl_xor(v, o);
    return v;
}
__device__ __forceinline__ float wave_max(float v) {
#pragma unroll
    for (int o = 1; o < 64; o <<= 1) v = fmaxf(v, __shfl_xor(v, o));
    return v;
}
__device__ __forceinline__ float sigmoidf_(float x) { return 1.0f / (1.0f + __expf(-x)); }
__device__ __forceinline__ float gelu_tanh(float x) { const float u = 0.7978845608028654f * (x + 0.044715f * x * x * x); return x / (1.0f + __expf(-2.0f * u)); }

__constant__ unsigned char BKT[3][132] = {
{0,1,2,3,4,5,6,7,8,9,10,11,12,13,14,15,16,16,16,16,16,16,17,17,17,17,17,17,17,17,18,18,18,18,18,18,18,18,18,18,19,19,19,19,19,19,19,19,19,19,19,19,19,19,20,20,20,20,20,20,20,20,20,20,20,20,20,20,20,20,20,20,20,21,21,21,21,21,21,21,21,21,21,21,21,21,21,21,21,21,21,21,21,21,21,21,21,21,21,22,22,22,22,22,22,22,22,22,22,22,22,22,22,22,22,22,22,22,22,22,22,22,22,22,22,22,22,22,22,0,0,0},
{0,4,8,12,16,16,17,17,18,18,19,19,19,19,20,20,20,20,20,21,21,21,21,21,21,22,22,22,22,22,22,22,22,22,23,23,23,23,23,23,23,23,23,23,23,23,24,24,24,24,24,24,24,24,24,24,24,24,24,24,24,24,25,25,25,25,25,25,25,25,25,25,25,25,25,25,25,25,25,25,25,25,25,26,26,26,26,26,26,26,26,26,26,26,26,26,26,26,26,26,26,26,26,26,26,26,26,26,26,26,26,26,26,27,27,27,27,27,27,27,27,27,27,27,27,27,27,27,27,0,0,0},
{0,16,18,19,20,21,21,22,22,23,23,23,24,24,24,24,25,25,25,25,25,26,26,26,26,26,26,26,26,27,27,27,27,27,27,27,27,27,27,28,28,28,28,28,28,28,28,28,28,28,28,28,29,29,29,29,29,29,29,29,29,29,29,29,29,29,29,29,29,29,30,30,30,30,30,30,30,30,30,30,30,30,30,30,30,30,30,30,30,30,30,30,30,30,30,31,31,31,31,31,31,31,31,31,31,31,31,31,31,31,31,31,31,31,31,31,31,31,31,31,31,31,31,31,31,31,31,31,31,0,0,0}};

#define XB_TMO      128
#define XB_XCNT(j)  (256  + 64 * (j))
#define XB_XSUB(j)  (1280 + 64 * (j))
#define XB_XGEN(j)  (2304 + 64 * (j))
#define XB_TOP      3328
#define XB_TOPGEN   3392
#define XCD_BAR_WORDS 3456
#define XB_SPIN_CAP (1u << 18)
__device__ __forceinline__ unsigned xb_ld(unsigned* p)              { return __hip_atomic_load(p, __ATOMIC_RELAXED, __HIP_MEMORY_SCOPE_AGENT); }
__device__ __forceinline__ unsigned xb_add(unsigned* p, unsigned v) { return __hip_atomic_fetch_add(p, v, __ATOMIC_RELAXED, __HIP_MEMORY_SCOPE_AGENT); }
__device__ __forceinline__ unsigned xb_xcc_id() { return (unsigned)__builtin_amdgcn_s_getreg((3 << 11) | 20) & 0xFu; }
#define XB_SPIN(cond, bar) do { unsigned _sp = 0; while (cond) { __builtin_amdgcn_s_sleep(1); \
    if ((++_sp & 255u) == 0u) { if (xb_ld(&(bar)[XB_TMO])) break; if (_sp > XB_SPIN_CAP) { atomicAdd(&(bar)[XB_TMO], 1u); break; } } } } while (0)
struct XcdBarrier { unsigned* bar; unsigned x; volatile LAS unsigned* st; };
__device__ __forceinline__ XcdBarrier xcd_barrier_post(unsigned* bar, volatile LAS unsigned* st) {
    XcdBarrier b; b.bar = bar; b.x = xb_xcc_id(); b.st = st;
    if (threadIdx.x == 0) (void)xb_add(&bar[XB_XCNT(b.x)], 1u);
    return b;
}
__device__ __forceinline__ void xcd_barrier_complete(unsigned* bar, unsigned x, unsigned& nloc, unsigned& nx) {
    const unsigned G = gridDim.x * gridDim.y * gridDim.z;
    unsigned sum, cnt, mine, sp = 0u;
    for (;;) {
        sum = 0u; cnt = 0u; mine = 0u;
#pragma unroll
        for (unsigned j = 0; j < 16; ++j) { const unsigned c = xb_ld(&bar[XB_XCNT(j)]); sum += c; cnt += (c > 0u) ? 1u : 0u; mine = (j == x) ? c : mine; }
        if (sum == G) break;
        __builtin_amdgcn_s_sleep(1);
        if ((++sp & 255u) == 0u) { if (xb_ld(&bar[XB_TMO])) break; if (sp > XB_SPIN_CAP) { atomicAdd(&bar[XB_TMO], 1u); break; } }
    }
    nloc = mine > 0u ? mine : 1u; nx = cnt > 0u ? cnt : 1u;
}
__device__ __forceinline__ void xcd_barrier(const XcdBarrier& b) {
    asm volatile("s_waitcnt vmcnt(0)" ::: "memory");
    __syncthreads();
    if (threadIdx.x == 0) {
        unsigned* bar = b.bar;
        __builtin_amdgcn_s_waitcnt(0);
        unsigned nloc = b.st[0], nx = b.st[1];
        if (nloc == 0u) { xcd_barrier_complete(bar, b.x, nloc, nx); b.st[0] = nloc; b.st[1] = nx; }
        const unsigned old = xb_add(&bar[XB_XSUB(b.x)], 1u);
        const unsigned gen = old / nloc;
        if (old + 1u == (gen + 1u) * nloc) {
            __builtin_amdgcn_fence(__ATOMIC_RELEASE, "agent");
            asm volatile("s_waitcnt vmcnt(0)" ::: "memory");
            const unsigned og = xb_add(&bar[XB_TOP], 1u);
            const unsigned tg = og / nx;
            if (og + 1u == (tg + 1u) * nx) xb_add(&bar[XB_TOPGEN], 1u);
            else XB_SPIN(xb_ld(&bar[XB_TOPGEN]) == tg, bar);
            __builtin_amdgcn_fence(__ATOMIC_ACQUIRE, "agent");
            xb_add(&bar[XB_XGEN(b.x)], 1u);
            asm volatile("s_waitcnt vmcnt(0)" ::: "memory");
        } else {
            XB_SPIN(xb_ld(&bar[XB_XGEN(b.x)]) == gen, bar);
            __builtin_amdgcn_fence(__ATOMIC_ACQUIRE, "agent");
            asm volatile("s_waitcnt vmcnt(0)" ::: "memory");
        }
    }
    __syncthreads();
}

namespace pg8 {
constexpr int BM = 256, BK = 64, HALF = 128, HTB = HALF * BK * 2, STAGE_BYTES = 8 * HTB, NXCD = 8, WGM = 8;
__host__ __device__ __forceinline__ int lds_byte(int r, int c) { const int st = (r >> 4) * 2 + (c >> 5), rr = r & 15, cc = c & 31, ob = rr * 64 + cc * 2; return st * 1024 + (ob ^ (((ob >> 9) & 1) << 5)); }
__host__ __device__ __forceinline__ void stage_rc(int b, int& R, int& C) { const int st = b / 1024, sb = b % 1024, swz = sb ^ (((sb >> 9) & 1) << 5); R = (st >> 1) * 16 + swz / 64; C = (st & 1) * 32 + (swz % 64) / 2; }
__host__ __device__ __forceinline__ int perm32(int rho) { const int n = rho >> 4, i = rho & 15; return 8 * (i >> 2) + 4 * n + (i & 3); }

struct Unit { int pm, pn, tag; size_t aoff, boff; };
struct Gemm { const bf16_t* A; const bf16_t* Bt; int lda, ldb, K; };

struct StaticOrder {
    int nM, nN, nwg, G, c; size_t astep, bstep;
    __device__ void init(int nM_, int nN_, int G_, int c_, int lda, int ldb) { nM = nM_; nN = nN_; nwg = nM * nN; G = G_; c = c_; astep = (size_t)BM * lda * 2; bstep = (size_t)BM * ldb * 2; }
    __device__ bool next(int i, Unit& u) const {
        const long L = (long)i * G + c; if (L >= nwg) return false;
        int wgid = (int)L; { const int q = nwg / NXCD, r = nwg % NXCD, xcd = wgid % NXCD, off = wgid / NXCD; wgid = (xcd < r ? xcd * (q + 1) : r * (q + 1) + (xcd - r) * q) + off; }
        const int nig = WGM * nN, gid = wgid / nig, fm = gid * WGM, gsz = (nM - fm) < WGM ? (nM - fm) : WGM;
        u.pm = fm + ((wgid % nig) % gsz); u.pn = (wgid % nig) / gsz; u.tag = 0; u.aoff = (size_t)u.pm * astep; u.boff = (size_t)u.pn * bstep; return true;
    }
};
struct BranchOrder {
    int G, vc, ntiles;
    __device__ bool next(int i, Unit& u) const {
        const int T = vc + G * (i >> 2); if (T >= ntiles) return false;
        const int g = i & 3; u.pm = T >> 3; u.pn = T & 7; u.tag = g;
        u.aoff = ((size_t)u.pm * BM * D + (size_t)g * BRW) * 2; u.boff = ((size_t)g * D + (size_t)u.pn * BM) * BRW * 2; return true;
    }
};

template <class Epi, class Sched>
__device__ __forceinline__ void gemm_phase(LAS unsigned char* lds, const Gemm g, const Sched& S, const Epi& E) {
    int lane = threadIdx.x & 63, wid = __builtin_amdgcn_readfirstlane(threadIdx.x >> 6); asm volatile("" : "+v"(lane)); asm volatile("" : "+s"(wid));
    const int tid = wid * 64 + lane, wr = wid >> 2, wc = wid & 3, fr = lane & 15, fq = lane >> 4;
    const int K = g.K, nt = K / BK;
    unsigned voffA[2], voffB[2];
#pragma unroll
    for (int i = 0; i < 2; ++i) { int R, C; stage_rc(tid * 16 + i * 8192, R, C); const int Rb = Epi::PERM ? ((R & ~31) + perm32(R & 31)) : R;
        voffA[i] = (unsigned)(R * g.lda + C) * 2u; voffB[i] = (unsigned)(Rb * g.ldb + C) * 2u; }
    const size_t kstep = (size_t)(BK * 2);
    const size_t hA = (size_t)HALF * g.lda * 2, hB = (size_t)HALF * g.ldb * 2;
    const unsigned ldsw = (unsigned)wid * 1024u;
    const int aoff = lds_byte(wr * 64 + fr, fq * 8), boff = lds_byte(wc * 32 + fr, fq * 8);
#define PG8_SA(b, h) (((b) * 2 + (h)) * HTB)
#define PG8_SB(b, h) ((4 + (b) * 2 + (h)) * HTB)
#define PG8_STAGE(bufoff, gbase, voff) do { _Pragma("unroll") for (int _i = 0; _i < 2; ++_i) \
        __builtin_amdgcn_global_load_lds((const unsigned*)((const char*)(gbase) + (voff)[_i]), (LAS unsigned*)(lds + (bufoff) + ldsw + _i * 8192), 16, 0, 0); } while (0)
#define PG8_LDA(dst, b, h) do { _Pragma("unroll") for (int m = 0; m < 4; ++m) _Pragma("unroll") for (int k = 0; k < 2; ++k) dst[m][k] = *(const LAS bf16x8*)(lds + PG8_SA(b, h) + aoff + m * 2048 + k * 1024); } while (0)
#define PG8_LDB(dst, b, h) do { _Pragma("unroll") for (int n = 0; n < 2; ++n) _Pragma("unroll") for (int k = 0; k < 2; ++k) dst[n][k] = *(const LAS bf16x8*)(lds + PG8_SB(b, h) + boff + n * 2048 + k * 1024); } while (0)
#define PG8_MMA(ai, bj, At, Bt) do { __builtin_amdgcn_s_setprio(1); _Pragma("unroll") for (int m = 0; m < 4; ++m) _Pragma("unroll") for (int n = 0; n < 2; ++n) _Pragma("unroll") for (int k = 0; k < 2; ++k) \
        acc[ai][bj][m][n] = __builtin_amdgcn_mfma_f32_16x16x32_bf16(Bt[n][k], At[m][k], acc[ai][bj][m][n], 0, 0, 0); __builtin_amdgcn_s_setprio(0); } while (0)
#define PG8_WAIT_V(n) asm volatile("s_waitcnt vmcnt(" #n ")" ::: "memory")
#define PG8_WAIT_L(n) asm volatile("s_waitcnt lgkmcnt(" #n ")" ::: "memory")
#define PG8_BAR __builtin_amdgcn_s_barrier()
#define PG8_SCHED __builtin_amdgcn_sched_barrier(0)
    Unit cur, nxt; int ui = 0;
    if (!S.next(0, cur)) return;
    f32x4 acc[2][2][4][2];
#pragma unroll
    for (int a = 0; a < 2; ++a)
#pragma unroll
        for (int b = 0; b < 2; ++b)
#pragma unroll
            for (int m = 0; m < 4; ++m)
#pragma unroll
                for (int n = 0; n < 2; ++n) acc[a][b][m][n] = (f32x4){0.f, 0.f, 0.f, 0.f};
    bf16x8 At[4][2], B0[2][2], B1[2][2];
    const char* cA = (const char*)g.A + cur.aoff; const char* cB = (const char*)g.Bt + cur.boff;
    PG8_STAGE(PG8_SB(0, 0), cB, voffB); PG8_STAGE(PG8_SB(0, 1), cB + hB, voffB); PG8_STAGE(PG8_SA(0, 0), cA, voffA); PG8_STAGE(PG8_SA(0, 1), cA + hA, voffA);
    if (wr == 1) PG8_BAR;
    PG8_WAIT_V(2); PG8_BAR;
    PG8_STAGE(PG8_SB(1, 0), cB + kstep, voffB); PG8_STAGE(PG8_SA(1, 0), cA + kstep, voffA); PG8_STAGE(PG8_SB(1, 1), cB + hB + kstep, voffB);
    PG8_WAIT_V(6); PG8_BAR;
    for (;;) {
        const bool has_next = S.next(ui + 1, nxt);
        const char* nA = has_next ? (const char*)g.A + nxt.aoff : cA; const char* nB = has_next ? (const char*)g.Bt + nxt.boff : cB;
        for (int t = 0; t < nt; t += 2) {
            const bool last = (t == nt - 2);
            const char* a1 = cA + (size_t)(t + 1) * kstep;
            const char* a2 = last ? nA : cA + (size_t)(t + 2) * kstep; const char* b2 = last ? nB : cB + (size_t)(t + 2) * kstep;
            const char* a3 = a2 + kstep; const char* b3 = b2 + kstep;
            PG8_LDB(B0, 0, 0); PG8_LDB(B1, 0, 1); PG8_SCHED; PG8_LDA(At, 0, 0); PG8_STAGE(PG8_SA(1, 1), a1 + hA, voffA);
            PG8_WAIT_V(8); PG8_WAIT_L(0); PG8_BAR; PG8_MMA(0, 0, At, B0); PG8_MMA(0, 1, At, B1); PG8_BAR; PG8_SCHED;
            PG8_LDA(At, 0, 1); PG8_STAGE(PG8_SB(0, 0), b2, voffB); PG8_STAGE(PG8_SB(0, 1), b2 + hB, voffB); PG8_STAGE(PG8_SA(0, 0), a2, voffA);
            PG8_WAIT_V(8); PG8_WAIT_L(0); PG8_BAR; PG8_MMA(1, 0, At, B0); PG8_MMA(1, 1, At, B1); PG8_BAR; PG8_SCHED;
            PG8_LDB(B0, 1, 0); PG8_LDB(B1, 1, 1); PG8_SCHED; PG8_LDA(At, 1, 0); PG8_STAGE(PG8_SA(0, 1), a2 + hA, voffA);
            PG8_WAIT_V(8); PG8_WAIT_L(0); PG8_BAR; PG8_MMA(0, 0, At, B0); PG8_MMA(0, 1, At, B1); PG8_BAR; PG8_SCHED;
            PG8_LDA(At, 1, 1); PG8_STAGE(PG8_SB(1, 0), b3, voffB); PG8_STAGE(PG8_SB(1, 1), b3 + hB, voffB); PG8_STAGE(PG8_SA(1, 0), a3, voffA);
            PG8_WAIT_V(8); PG8_WAIT_L(0); PG8_BAR; PG8_MMA(1, 0, At, B0); PG8_MMA(1, 1, At, B1); PG8_BAR; PG8_SCHED;
        }
        if (wr == 0) PG8_BAR;
        E(acc, cur, wr, wc, fr, fq);
        if (!has_next) break;
#pragma unroll
        for (int a = 0; a < 2; ++a)
#pragma unroll
            for (int b = 0; b < 2; ++b)
#pragma unroll
                for (int m = 0; m < 4; ++m)
#pragma unroll
                    for (int n = 0; n < 2; ++n) acc[a][b][m][n] = (f32x4){0.f, 0.f, 0.f, 0.f};
        cur = nxt; cA = nA; cB = nB; ++ui;
        if (wr == 1) PG8_BAR;
    }
    PG8_WAIT_V(0);
    PG8_BAR;
#undef PG8_SA
#undef PG8_SB
#undef PG8_STAGE
#undef PG8_LDA
#undef PG8_LDB
#undef PG8_MMA
#undef PG8_WAIT_V
#undef PG8_WAIT_L
#undef PG8_BAR
#undef PG8_SCHED
}

struct Epi1 {
    static constexpr bool PERM = true;
    bf16_t* P; bf16_t* G; const float* bg;
    __device__ __forceinline__ void operator()(const f32x4 (&acc)[2][2][4][2], const Unit& u, int wr, int wc, int fr, int fq) const {
        const int row0 = u.pm * BM + wr * 64 + fr, ct = u.pn * BM, cw = wc * 32 + 8 * fq;
        if (ct < NIN) {
            const bool gelu = ct < 1024;
#pragma unroll
            for (int ai = 0; ai < 2; ++ai)
#pragma unroll
                for (int m = 0; m < 4; ++m) { bf16_t* rowp = P + (size_t)(row0 + ai * HALF + m * 16) * NIN + ct + cw;
#pragma unroll
                    for (int bj = 0; bj < 2; ++bj) { f32x4 v0 = acc[ai][bj][m][0], v1 = acc[ai][bj][m][1];
                        if (gelu) {
#pragma unroll
                            for (int j = 0; j < 4; ++j) { v0[j] = gelu_tanh(v0[j]); v1[j] = gelu_tanh(v1[j]); } }
                        u32x4 w; w.x = cvt_pk_bf16(v0[0], v0[1]); w.y = cvt_pk_bf16(v0[2], v0[3]); w.z = cvt_pk_bf16(v1[0], v1[1]); w.w = cvt_pk_bf16(v1[2], v1[3]);
                        *(u32x4*)(rowp + bj * HALF) = w; } }
        } else {
            const int cg = ct - NIN + cw;
            f32x4 bv[2][2];
#pragma unroll
            for (int bj = 0; bj < 2; ++bj)
#pragma unroll
                for (int n = 0; n < 2; ++n) bv[bj][n] = *(const f32x4*)(bg + cg + bj * HALF + 4 * n);
#pragma unroll
            for (int ai = 0; ai < 2; ++ai)
#pragma unroll
                for (int m = 0; m < 4; ++m) { bf16_t* rowp = G + (size_t)(row0 + ai * HALF + m * 16) * NGATE + cg;
#pragma unroll
                    for (int bj = 0; bj < 2; ++bj) { f32x4 v0 = acc[ai][bj][m][0] + bv[bj][0], v1 = acc[ai][bj][m][1] + bv[bj][1];
#pragma unroll
                        for (int j = 0; j < 4; ++j) { v0[j] = sigmoidf_(v0[j]); v1[j] = sigmoidf_(v1[j]); }
                        u32x4 w; w.x = cvt_pk_bf16(v0[0], v0[1]); w.y = cvt_pk_bf16(v0[2], v0[3]); w.z = cvt_pk_bf16(v1[0], v1[1]); w.w = cvt_pk_bf16(v1[2], v1[3]);
                        *(u32x4*)(rowp + bj * HALF) = w; } }
        }
    }
};
struct Epi2 {
    static constexpr bool PERM = true;
    const bf16_t* G; bf16_t* O; float* slab;
    __device__ __forceinline__ void operator()(const f32x4 (&acc)[2][2][4][2], const Unit& u, int wr, int wc, int fr, int fq) const {
        const int g = u.tag, row0 = u.pm * BM + wr * 64 + fr, cw = u.pn * BM + wc * 32 + 8 * fq;
        float* sl = slab + (size_t)threadIdx.x * 4; asm volatile("" : "+v"(sl));
#pragma unroll
        for (int ai = 0; ai < 2; ++ai)
#pragma unroll
            for (int m = 0; m < 4; ++m) { const size_t row = (size_t)(row0 + ai * HALF + m * 16);
#pragma unroll
                for (int bj = 0; bj < 2; ++bj) {
                    const u32x4 gw = *(const u32x4*)(G + row * NGATE + (size_t)g * D + cw + bj * HALF);
                    f32x4 v0 = acc[ai][bj][m][0] * (f32x4){bflo(gw.x), bfhi(gw.x), bflo(gw.y), bfhi(gw.y)};
                    f32x4 v1 = acc[ai][bj][m][1] * (f32x4){bflo(gw.z), bfhi(gw.z), bflo(gw.w), bfhi(gw.w)};
                    float* s0 = sl + (size_t)((((ai * 4 + m) * 2 + bj) * 2 + 0) * 2048), *s1 = s0 + 2048;
                    if (g > 0) { v0 += *(const f32x4*)s0; v1 += *(const f32x4*)s1; }
                    if (g < 3) { *(f32x4*)s0 = v0; *(f32x4*)s1 = v1; }
                    else { u32x4 w; w.x = cvt_pk_bf16(v0[0], v0[1]); w.y = cvt_pk_bf16(v0[2], v0[3]); w.z = cvt_pk_bf16(v1[0], v1[1]); w.w = cvt_pk_bf16(v1[2], v1[3]);
                        *(u32x4*)(O + row * D + cw + bj * HALF) = w; } }
                asm volatile("" ::: "memory"); }
    }
};
struct EpiRes {
    static constexpr bool PERM = false;
    float* X; const float* modl; int jg;
    __device__ __forceinline__ void operator()(const f32x4 (&acc)[2][2][4][2], const Unit& u, int wr, int wc, int fr, int fq) const {
        const int row0 = u.pm * BM + wr * 64 + fr, col0 = u.pn * BM + wc * 32 + 4 * fq;
#pragma unroll
        for (int ai = 0; ai < 2; ++ai)
#pragma unroll
            for (int m = 0; m < 4; ++m) { const int row = row0 + ai * HALF + m * 16;
                int bb = row < MP ? (row >> 12) : (NBP + ((row - MP) >> 2)); bb = bb < NBB ? bb : NBB - 1;
                const float* gp = modl + (size_t)(bb * 6 + jg) * D + col0; float* xp = X + (size_t)row * D + col0;
#pragma unroll
                for (int bj = 0; bj < 2; ++bj)
#pragma unroll
                    for (int n = 0; n < 2; ++n) { const f32x4 gv = *(const f32x4*)(gp + bj * HALF + n * 16); const f32x4 xv = *(const f32x4*)(xp + bj * HALF + n * 16);
                        *(f32x4*)(xp + bj * HALF + n * 16) = xv + gv * acc[ai][bj][m][n]; }
                asm volatile("" ::: "memory"); }
    }
};
struct EpiSwi {
    static constexpr bool PERM = true;
    bf16_t* H;
    __device__ __forceinline__ void operator()(const f32x4 (&acc)[2][2][4][2], const Unit& u, int wr, int wc, int fr, int fq) const {
        const int row0 = u.pm * BM + wr * 64 + fr, c0 = u.pn * HALF + wc * 32 + 8 * fq;
#pragma unroll
        for (int ai = 0; ai < 2; ++ai)
#pragma unroll
            for (int m = 0; m < 4; ++m) { bf16_t* rowp = H + (size_t)(row0 + ai * HALF + m * 16) * DFF + c0;
                f32x4 v0, v1;
#pragma unroll
                for (int j = 0; j < 4; ++j) { const float a0 = acc[ai][0][m][0][j], a1 = acc[ai][0][m][1][j]; v0[j] = a0 * sigmoidf_(a0) * acc[ai][1][m][0][j]; v1[j] = a1 * sigmoidf_(a1) * acc[ai][1][m][1][j]; }
                u32x4 w; w.x = cvt_pk_bf16(v0[0], v0[1]); w.y = cvt_pk_bf16(v0[2], v0[3]); w.z = cvt_pk_bf16(v1[0], v1[1]); w.w = cvt_pk_bf16(v1[2], v1[3]);
                *(u32x4*)rowp = w; }
    }
};
}

enum { I_XP = 0, I_XS, I_CP, I_CS, I_CB1, I_CB2, I_CB3, I_CPOOL, I_CCONV, I_LN1G, I_LN2G, I_WADA, I_BADA, I_WIN, I_WGATE, I_BGATE, I_ALNG, I_ALNB, I_AWS, I_ABS, I_RELB, I_POOLW, I_POOLB, I_POOLS, I_CONVW, I_WBR, I_WOUT, I_W1, I_W3, I_W2, I_FING };
__device__ __forceinline__ const float* inp(int i) {
    const __attribute__((address_space(4))) char* kp = (const __attribute__((address_space(4))) char*)__builtin_amdgcn_kernarg_segment_ptr();
    return *(const float* const volatile __attribute__((address_space(4)))*)(kp + 8 * i);
}
struct Frame {
    LAS unsigned char* lds;
    int tid, lane, wave, vcu, G;
    float* out; unsigned char* ws;
    __device__ __forceinline__ float* MOD() const { return (float*)(ws + WS_MOD); }
    __device__ __forceinline__ float* MODP() const { return (float*)(ws + WS_MODP); }
    __device__ __forceinline__ float* X() const { return (float*)(ws + WS_X); }
    __device__ __forceinline__ float* LSE() const { return (float*)(ws + WS_LSE); }
    __device__ __forceinline__ float* ACC() const { return (float*)(ws + WS_ACC); }
    __device__ __forceinline__ bf16_t* POOLWT() const { return (bf16_t*)(ws + WS_POOLWT); }
    __device__ __forceinline__ bf16_t* HN() const { return (bf16_t*)(ws + WS_HN); }
    __device__ __forceinline__ bf16_t* P() const { return (bf16_t*)(ws + WS_P); }
    __device__ __forceinline__ bf16_t* GATES() const { return (bf16_t*)(ws + WS_GATES); }
    __device__ __forceinline__ bf16_t* YS() const { return (bf16_t*)(ws + WS_YS); }
    __device__ __forceinline__ bf16_t* OG() const { return (bf16_t*)(ws + WS_OG); }
    __device__ __forceinline__ bf16_t* MERGED() const { return (bf16_t*)(ws + WS_MERGED); }
    __device__ __forceinline__ bf16_t* H() const { return (bf16_t*)(ws + WS_H); }
};

#define OPAQUE_IDS(F) int lane = (F).lane, wave = (F).wave; asm volatile("" : "+v"(lane)); asm volatile("" : "+s"(wave)); const int tid = wave * 64 + lane; (void)tid
__device__ __forceinline__ unsigned f2bf(float f) { unsigned u = __float_as_uint(f); return (u + 0x7fffu + ((u >> 16) & 1u)) >> 16; }
__device__ __forceinline__ unsigned pk2(float lo, float hi) { return f2bf(lo) | (f2bf(hi) << 16); }
__device__ __forceinline__ void transpose_item(const float* W, int N, int k0, int n0, bf16_t* WT, int ldk, int drow0, LAS float* scr, int lane) {
#pragma unroll 8
    for (int i = 0; i < 32; ++i) { const int kk = 2 * i + (lane >> 5); scr[kk * 33 + (lane & 31)] = W[(size_t)(k0 + kk) * N + n0 + (lane & 31)]; }
    asm volatile("s_waitcnt lgkmcnt(0)" ::: "memory");
    const int c = lane & 7;
#pragma unroll
    for (int j = 0; j < 4; ++j) { const int n = (lane >> 3) + 8 * j; const LAS float* s = scr + (8 * c) * 33 + n;
        u32x4 o; o.x = pk2(s[0 * 33], s[1 * 33]); o.y = pk2(s[2 * 33], s[3 * 33]); o.z = pk2(s[4 * 33], s[5 * 33]); o.w = pk2(s[6 * 33], s[7 * 33]);
        *(u32x4*)(WT + (size_t)(drow0 + n) * ldk + k0 + 8 * c) = o; }
    asm volatile("s_waitcnt lgkmcnt(0)" ::: "memory");
}
__device__ __forceinline__ void p0a_phase(const Frame& F) {
    OPAQUE_IDS(F);
    {
        LAS float* sl = (LAS float*)F.lds;
        LAS float* red = (LAS float*)(F.lds + 8192);
        const float* cpr = inp(I_CP); const float* csm = inp(I_CS); const float* wada = inp(I_WADA);
        for (int u = F.vcu; u < 768; u += F.G) {
            const int l = u / 192, rem = u % 192, cb = rem >> 4, ks = rem & 15;
            __syncthreads();
            for (int i = tid; i < 1280; i += NTHREADS) { const int bb = i >> 7, kk = i & 127;
                const float c = bb < NBP ? cpr[bb * D + ks * 128 + kk] : csm[(bb - NBP) * D + ks * 128 + kk];
                sl[i] = c / (1.0f + __expf(-c)); }
            __syncthreads();
            const int ct = tid & 255, kh = tid >> 8;
            const float* wp = wada + ((size_t)(l * D + ks * 128 + kh * 64)) * (6 * D) + cb * 1024 + ct * 4;
            f32x4 acc[NBB];
#pragma unroll
            for (int b = 0; b < NBB; ++b) acc[b] = (f32x4){0.f, 0.f, 0.f, 0.f};
#pragma unroll 8
            for (int kk = 0; kk < 64; ++kk) { const f32x4 w = *(const f32x4*)(wp + (size_t)kk * (6 * D));
#pragma unroll
                for (int b = 0; b < NBB; ++b) acc[b] += sl[b * 128 + kh * 64 + kk] * w; }
            if (kh == 1) {
#pragma unroll
                for (int b = 0; b < NBB; ++b) *(LAS f32x4*)(red + (ct * NBB + b) * 4) = acc[b]; }
            __syncthreads();
            if (kh == 0) {
#pragma unroll
                for (int b = 0; b < NBB; ++b) { const f32x4 o = acc[b] + *(const LAS f32x4*)(red + (ct * NBB + b) * 4);
                    *(f32x4*)(F.MODP() + ((size_t)((ks * DEPTH + l) * NBB + b)) * (6 * D) + cb * 1024 + ct * 4) = o; } }
        }
        __syncthreads();
    }
    {
        LAS float* scr = (LAS float*)(F.lds + wave * 16384);
        const int gw = F.vcu * NWAVES + wave, NGW = F.G * NWAVES;
        constexpr int C_IN = 32 * (NIN / 32), C_GATE = 32 * (NGATE / 32), C_BR = 8 * (D / 32), C_OUT = 32 * (D / 32), C_W1 = 32 * (DFF / 32), C_W2 = (DFF / 64) * (D / 32), C_PW = 2 * 4;
        constexpr int C_LAYER = C_IN + C_GATE + 4 * C_BR + C_OUT + 2 * C_W1 + C_W2 + 4 * C_PW;
        for (int it = gw; it < DEPTH * C_LAYER; it += NGW) {
            const int l = it / C_LAYER; int r = it % C_LAYER;
            if (r < C_IN) { const int nblk = NIN / 32, kb = r / nblk, nb = r % nblk; transpose_item(inp(I_WIN) + (size_t)l * D * NIN, NIN, 64 * kb, 32 * nb, (bf16_t*)(F.ws + WS_BT1 + l * BT1_L), D, 32 * nb, scr, lane); continue; } r -= C_IN;
            if (r < C_GATE) { const int nblk = NGATE / 32, kb = r / nblk, nb = r % nblk; transpose_item(inp(I_WGATE) + (size_t)l * D * NGATE, NGATE, 64 * kb, 32 * nb, (bf16_t*)(F.ws + WS_BT1 + l * BT1_L), D, NIN + 32 * nb, scr, lane); continue; } r -= C_GATE;
            if (r < 4 * C_BR) { const int g = r / C_BR, rr = r % C_BR, nblk = D / 32, kb = rr / nblk, nb = rr % nblk;
                transpose_item(inp(I_WBR) + ((size_t)(l * 4 + g)) * BRW * D, D, 64 * kb, 32 * nb, (bf16_t*)(F.ws + WS_BT2 + l * BT2_L) + (size_t)g * D * BRW, BRW, 32 * nb, scr, lane); continue; } r -= 4 * C_BR;
            if (r < C_OUT) { const int nblk = D / 32, kb = r / nblk, nb = r % nblk; transpose_item(inp(I_WOUT) + (size_t)l * D * D, D, 64 * kb, 32 * nb, (bf16_t*)(F.ws + WS_BT3 + l * BT3_L), D, 32 * nb, scr, lane); continue; } r -= C_OUT;
            if (r < 2 * C_W1) { const int which = r / C_W1, rr = r % C_W1, nblk = DFF / 32, kb = rr / nblk, nb = rr % nblk, n0 = 32 * nb;
                transpose_item((which ? inp(I_W3) : inp(I_W1)) + (size_t)l * D * DFF, DFF, 64 * kb, n0, (bf16_t*)(F.ws + WS_BT4 + l * BT4_L), D, (n0 >> 7) * 256 + which * 128 + (n0 & 127), scr, lane); continue; } r -= 2 * C_W1;
            if (r < C_W2) { const int nblk = D / 32, kb = r / nblk, nb = r % nblk; transpose_item(inp(I_W2) + (size_t)l * DFF * D, D, 64 * kb, 32 * nb, (bf16_t*)(F.ws + WS_BT5 + l * BT5_L), DFF, 32 * nb, scr, lane); continue; } r -= C_W2;
            { const int g = r / C_PW, rr = r % C_PW, kb = rr / 4, nb = rr % 4;
                transpose_item(inp(I_POOLW) + ((size_t)(l * 4 + g)) * 128 * 128, 128, 64 * kb, 32 * nb, F.POOLWT() + ((size_t)(l * 4 + g)) * 128 * 128, 128, 32 * nb, scr, lane); }
        }
        const float* xpr = inp(I_XP); const float* xsm = inp(I_XS);
        for (int row = gw; row < MREAL; row += NGW) {
            const f32x4* src = (const f32x4*)(row < MP ? xpr + (size_t)row * D : xsm + (size_t)(row - MP) * D) + lane; f32x4* dst = (f32x4*)(F.X() + (size_t)row * D) + lane;
#pragma unroll
            for (int j = 0; j < 8; ++j) dst[64 * j] = src[64 * j];
        }
    }
}
__device__ __forceinline__ void p0b_phase(const Frame& F) {
    const int n = DEPTH * NBB * 6 * D;
    const float* bada = inp(I_BADA); const float* l1g = inp(I_LN1G); const float* l2g = inp(I_LN2G);
    OPAQUE_IDS(F);
    for (int i = F.vcu * NTHREADS + tid; i < n; i += F.G * NTHREADS) {
        const int k = i & (D - 1), j = (i >> 11) % 6, bb = (i / (6 * D)) % NBB, l = i / (NBB * 6 * D), col = j * D + k;
        float s = bada[l * 6 * D + col];
#pragma unroll
        for (int ks = 0; ks < 16; ++ks) s += F.MODP()[((size_t)((ks * DEPTH + l) * NBB + bb)) * (6 * D) + col];
        if (j == 1) s = l1g[l * D + k] * (1.0f + s);
        if (j == 4) s = l2g[l * D + k] * (1.0f + s);
        F.MOD()[i] = s;
    }
}
__device__ __forceinline__ void norm_phase(const Frame& F, const float* modl, int jS, int jSH) {
    OPAQUE_IDS(F);
    const int gw = F.vcu * NWAVES + wave, NGW = F.G * NWAVES;
    for (int row = gw; row < MREAL; row += NGW) {
        const int bb = row < MP ? (row >> 12) : (NBP + ((row - MP) >> 2));
        const f32x4* xr = (const f32x4*)(F.X() + (size_t)row * D) + lane;
        f32x4 v[8]; float ss = 0.f;
#pragma unroll
        for (int j = 0; j < 8; ++j) { v[j] = xr[64 * j]; ss += (v[j].x * v[j].x + v[j].y * v[j].y) + (v[j].z * v[j].z + v[j].w * v[j].w); }
        const float rstd = 1.0f / sqrtf(wave_sum(ss) * (1.0f / D) + RMS_EPS);
        const f32x4* sp = (const f32x4*)(modl + (size_t)(bb * 6 + jS) * D) + lane; const f32x4* hp = (const f32x4*)(modl + (size_t)(bb * 6 + jSH) * D) + lane;
        u32x2* o = (u32x2*)(F.HN() + (size_t)row * D) + lane;
#pragma unroll
        for (int j = 0; j < 8; ++j) { const f32x4 s = sp[64 * j], h = hp[64 * j]; const f32x4 y = v[j] * rstd * s + h;
            u32x2 w; w.x = cvt_pk_bf16(y.x, y.y); w.y = cvt_pk_bf16(y.z, y.w); o[64 * j] = w; }
    }
}
__device__ __forceinline__ void final_norm_phase(const Frame& F) {
    OPAQUE_IDS(F);
    const int gw = F.vcu * NWAVES + wave, NGW = F.G * NWAVES;
    const float* fing = inp(I_FING);
    for (int row = gw; row < MREAL; row += NGW) {
        const f32x4* xr = (const f32x4*)(F.X() + (size_t)row * D) + lane;
        f32x4 v[8]; float ss = 0.f;
#pragma unroll
        for (int j = 0; j < 8; ++j) { v[j] = xr[64 * j]; ss += (v[j].x * v[j].x + v[j].y * v[j].y) + (v[j].z * v[j].z + v[j].w * v[j].w); }
        const float rstd = 1.0f / sqrtf(wave_sum(ss) * (1.0f / D) + RMS_EPS);
        const f32x4* gp = (const f32x4*)fing + lane; f32x4* o = (f32x4*)(F.out + OUT_Y + (size_t)row * D) + lane;
#pragma unroll
        for (int j = 0; j < 8; ++j) o[64 * j] = v[j] * rstd * gp[64 * j];
    }
}

constexpr int TP = 272;
constexpr int L_KBUF = 0, L_VRAW = 128 * TP, L_VT = 2 * 128 * TP, L_BT = 3 * 128 * TP;
template <bool PERMK> __device__ __forceinline__ void lds_transpose(LAS unsigned char* raw, LAS unsigned char* vt, int tid) {
#pragma unroll
    for (int i = 0; i < 4; ++i) { const int task = tid + NTHREADS * i, c = task & 127, sq = task >> 7, s = sq >> 2, q = sq & 3;
        unsigned short e[8];
#pragma unroll
        for (int jj = 0; jj < 8; ++jj) { const int row = PERMK ? (32 * s + 16 * (jj >> 2) + 4 * q + (jj & 3)) : (32 * s + 8 * q + jj); e[jj] = *(const LAS unsigned short*)(raw + row * TP + c * 2); }
        u32x4 w; w.x = e[0] | ((unsigned)e[1] << 16); w.y = e[2] | ((unsigned)e[3] << 16); w.z = e[4] | ((unsigned)e[5] << 16); w.w = e[6] | ((unsigned)e[7] << 16);
        *(LAS u32x4*)(vt + c * TP + (32 * s + 8 * q) * 2) = w; }
}
__device__ __forceinline__ void attn_prompt_unit(const Frame& F, int idx) {
    OPAQUE_IDS(F); const int fr = lane & 15, fq = lane >> 4;
    const int gi = idx >> 8, rem = idx & 255, h = rem & 3, blk = rem >> 2, b = blk >> 5, rb = blk & 31;
    const int dsh = 2 * gi, dm = (1 << dsh) - 1, r = rb & dm, n = rb >> dsh;
    const bf16_t* Pb = F.P() + (size_t)(b * SEQ) * NIN;
    const int qcol = 1024 + gi * 1536 + h * 128, kcol = qcol + 512, vcol = qcol + 1024;
    LAS unsigned char* kbuf = F.lds + L_KBUF; LAS unsigned char* vraw = F.lds + L_VRAW; LAS unsigned char* vt = F.lds + L_VT; LAS float* bt = (LAS float*)(F.lds + L_BT);
    __syncthreads();
    if (tid < 129) bt[tid] = inp(I_RELB)[(int)BKT[gi][tid] * 12 + gi * 4 + h];
    const int iq = 16 * wave + fr;
    const size_t qpos = ((size_t)(128 * n + iq) << dsh) + r;
    bf16x8 qf[4];
#pragma unroll
    for (int s = 0; s < 4; ++s) qf[s] = *(const bf16x8*)(Pb + qpos * NIN + qcol + 32 * s + 8 * fq);
    f32x4 S[16];
#pragma unroll
    for (int t = 0; t < 16; ++t) S[t] = (f32x4){0.f, 0.f, 0.f, 0.f};
    const int hf0 = (n == 0) ? 1 : 0;
#pragma unroll
    for (int hf = 0; hf < 2; ++hf) {
        if (hf >= hf0) {
#pragma unroll
            for (int i = 0; i < 4; ++i) { const int c = tid + NTHREADS * i, row = c >> 4, ch = c & 15; const size_t pk = ((size_t)(128 * (n - 1 + hf) + row) << dsh) + r;
                *(LAS u32x4*)(kbuf + row * TP + ch * 16) = *(const u32x4*)(Pb + pk * NIN + kcol + ch * 8); }
            __syncthreads();
#pragma unroll
            for (int t = 0; t < 8; ++t)
#pragma unroll
                for (int s = 0; s < 4; ++s) { const bf16x8 kf = *(const LAS bf16x8*)(kbuf + (16 * t + fr) * TP + 64 * s + 16 * fq);
                    S[hf * 8 + t] = __builtin_amdgcn_mfma_f32_16x16x32_bf16(kf, qf[s], S[hf * 8 + t], 0, 0, 0); if (s == 3 && (t & 1)) __builtin_amdgcn_sched_barrier(0); }
            __syncthreads();
        }
    }
    float mx = -3.0e38f;
#pragma unroll
    for (int T = 0; T < 16; ++T)
#pragma unroll
        for (int j = 0; j < 4; ++j) { const int jb = 16 * T + 4 * fq + j, diff = 128 + iq - jb; const bool valid = (diff >= 0) && (diff <= 128) && (jb >= 128 * hf0);
            const float lg = valid ? S[T][j] * ATT_SCALE + bt[valid ? diff : 0] : -1.0e30f; S[T][j] = lg; mx = fmaxf(mx, lg); if (j == 3) __builtin_amdgcn_sched_barrier(0); }
    mx = fmaxf(mx, __shfl_xor(mx, 16)); mx = fmaxf(mx, __shfl_xor(mx, 32));
    float sum = 0.f;
#pragma unroll
    for (int T = 0; T < 16; ++T)
#pragma unroll
        for (int j = 0; j < 4; ++j) { const float p = S[T][j] > -1.0e29f ? __expf(S[T][j] - mx) : 0.f; S[T][j] = p; sum += p; if (j == 3) __builtin_amdgcn_sched_barrier(0); }
    sum += __shfl_xor(sum, 16); sum += __shfl_xor(sum, 32);
    const float inv = 1.0f / sum, lse = mx + __logf(sum);
    bf16x8 pf[8];
#pragma unroll
    for (int ks = 0; ks < 8; ++ks) { const f32x4 a = S[2 * ks] * inv, c = S[2 * ks + 1] * inv;
        u32x4 w; w.x = cvt_pk_bf16(a[0], a[1]); w.y = cvt_pk_bf16(a[2], a[3]); w.z = cvt_pk_bf16(c[0], c[1]); w.w = cvt_pk_bf16(c[2], c[3]); pf[ks] = __builtin_bit_cast(bf16x8, w); }
    f32x4 O[8];
#pragma unroll
    for (int et = 0; et < 8; ++et) O[et] = (f32x4){0.f, 0.f, 0.f, 0.f};
#pragma unroll
    for (int hf = 0; hf < 2; ++hf) {
        if (hf >= hf0) {
#pragma unroll
            for (int i = 0; i < 4; ++i) { const int c = tid + NTHREADS * i, row = c >> 4, ch = c & 15; const size_t pk = ((size_t)(128 * (n - 1 + hf) + row) << dsh) + r;
                *(LAS u32x4*)(vraw + row * TP + ch * 16) = *(const u32x4*)(Pb + pk * NIN + vcol + ch * 8); }
            __syncthreads();
            lds_transpose<true>(vraw, vt, tid);
            __syncthreads();
#pragma unroll
            for (int s = 0; s < 4; ++s)
#pragma unroll
                for (int et = 0; et < 8; ++et) { const bf16x8 vf = *(const LAS bf16x8*)(vt + (16 * et + fr) * TP + 64 * s + 16 * fq);
                    O[et] = __builtin_amdgcn_mfma_f32_16x16x32_bf16(vf, pf[hf * 4 + s], O[et], 0, 0, 0); if (et == 7) __builtin_amdgcn_sched_barrier(0); }
        }
    }
    const size_t orow = (size_t)gi * MP + (size_t)b * SEQ + qpos;
    bf16_t* op = F.OG() + orow * BRW + h * 128 + 4 * fq;
#pragma unroll
    for (int et = 0; et < 8; ++et) { u32x2 w; w.x = cvt_pk_bf16(O[et][0], O[et][1]); w.y = cvt_pk_bf16(O[et][2], O[et][3]); *(u32x2*)(op + 16 * et) = w; }
    if (fq == 0) F.LSE()[orow * 4 + h] = lse;
}
__device__ __forceinline__ void gmlp_prompt_unit(const Frame& F, int l, int idx) {
    OPAQUE_IDS(F); const int fr = lane & 15, fq = lane >> 4;
    const int g = idx & 3, chunk = idx >> 2; const size_t row0 = (size_t)chunk * 128;
    LAS unsigned char* vraw = F.lds + L_VRAW; LAS unsigned char* vt = F.lds + L_VT;
    __syncthreads();
    {
        const int myg = lane >> 4, cl = (lane & 15) * 8; const float* alng = inp(I_ALNG); const float* alnb = inp(I_ALNB);
        float lg[8], lb[8];
#pragma unroll
        for (int i = 0; i < 8; ++i) { lg[i] = alng[l * BRW + myg * 128 + cl + i]; lb[i] = alnb[l * BRW + myg * 128 + cl + i]; }
#pragma unroll 4
        for (int rr = 0; rr < 16; ++rr) { const int j = 16 * wave + rr;
            const u32x4 raw = *(const u32x4*)(F.P() + (row0 + j) * NIN + 512 + lane * 8);
            float x[8]; unpack8(raw, x);
            float s = 0.f;
#pragma unroll
            for (int i = 0; i < 8; ++i) s += x[i];
            const float mean = wave_sum(s) * (1.0f / BRW); float q = 0.f;
#pragma unroll
            for (int i = 0; i < 8; ++i) { x[i] -= mean; q += x[i] * x[i]; }
            const float rstd = 1.0f / sqrtf(wave_sum(q) * (1.0f / BRW) + LN_EPS);
            if (myg == g) { float y[8];
#pragma unroll
                for (int i = 0; i < 8; ++i) y[i] = x[i] * rstd * lg[i] + lb[i];
                *(LAS u32x4*)(vraw + j * TP + (lane & 15) * 16) = pack8(y); }
        }
    }
    __syncthreads();
    lds_transpose<false>(vraw, vt, tid);
    __syncthreads();
    const int i_row = 16 * wave + fr; const float* aws = inp(I_AWS);
    f32x4 acc[8];
#pragma unroll
    for (int ct = 0; ct < 8; ++ct) acc[ct] = (f32x4){0.f, 0.f, 0.f, 0.f};
#pragma unroll
    for (int s = 0; s < 4; ++s) {
        if (32 * s <= 16 * wave + 15) {
            const float* wsp = aws + ((size_t)((l * 4 + g) * 128 + i_row)) * 128 + 32 * s + 8 * fq;
            const f32x4 w0 = *(const f32x4*)wsp, w1 = *(const f32x4*)(wsp + 4);
            float wv[8] = {w0[0], w0[1], w0[2], w0[3], w1[0], w1[1], w1[2], w1[3]};
#pragma unroll
            for (int jj = 0; jj < 8; ++jj) wv[jj] = (32 * s + 8 * fq + jj <= i_row) ? wv[jj] : 0.f;
            const bf16x8 wf = __builtin_bit_cast(bf16x8, pack8(wv));
#pragma unroll
            for (int ct = 0; ct < 8; ++ct) { const bf16x8 vf = *(const LAS bf16x8*)(vt + (16 * ct + fr) * TP + 64 * s + 16 * fq);
                acc[ct] = __builtin_amdgcn_mfma_f32_16x16x32_bf16(vf, wf, acc[ct], 0, 0, 0); }
        }
    }
    const float bsv = inp(I_ABS)[(l * 4 + g) * 128 + i_row];
#pragma unroll
    for (int ct = 0; ct < 8; ++ct) { const int c0 = g * 128 + 16 * ct + 4 * fq;
        const u32x2 uw = *(const u32x2*)(F.P() + (row0 + i_row) * NIN + c0);
        const float y0 = bflo(uw.x) * (acc[ct][0] + bsv), y1 = bfhi(uw.x) * (acc[ct][1] + bsv), y2 = bflo(uw.y) * (acc[ct][2] + bsv), y3 = bfhi(uw.y) * (acc[ct][3] + bsv);
        u32x2 w; w.x = cvt_pk_bf16(y0, y1); w.y = cvt_pk_bf16(y2, y3); *(u32x2*)(F.YS() + (row0 + i_row) * D + c0) = w; }
}
__device__ __forceinline__ void pool_prompt_unit(const Frame& F, int l, int idx) {
    OPAQUE_IDS(F); const int fr = lane & 15, fq = lane >> 4;
    const int gi = idx & 3, tile = idx >> 2, win = 2 << gi;
    const int t = ((tile & 31) << 7) + 16 * wave + fr;
    const size_t row = (size_t)tile * 128 + 16 * wave + fr;
    const float icnt = 1.0f / (float)((t + 1) < win ? (t + 1) : win);
    f32x4 acc[8];
#pragma unroll
    for (int dt = 0; dt < 8; ++dt) acc[dt] = (f32x4){0.f, 0.f, 0.f, 0.f};
    const bf16_t* pw = F.POOLWT() + ((size_t)(l * 4 + gi)) * 128 * 128; const float* poolb = inp(I_POOLB); const float* pools = inp(I_POOLS);
#pragma unroll
    for (int s = 0; s < 4; ++s) {
        const bf16_t* pc = F.P() + row * NIN + 5632 + gi * 128 + 32 * s + 8 * fq;
        float sum[8], cur[8];
        unpack8(*(const u32x4*)pc, cur);
#pragma unroll
        for (int i = 0; i < 8; ++i) sum[i] = cur[i];
        for (int k = 1; k < win; ++k) { if (t - k >= 0) { float v[8]; unpack8(*(const u32x4*)(pc - (size_t)k * NIN), v);
#pragma unroll
                for (int i = 0; i < 8; ++i) sum[i] += v[i]; } }
        float pl[8];
#pragma unroll
        for (int i = 0; i < 8; ++i) pl[i] = sum[i] * icnt - cur[i];
        const bf16x8 bfrag = __builtin_bit_cast(bf16x8, pack8(pl));
#pragma unroll
        for (int dt = 0; dt < 8; ++dt) { const bf16x8 af = *(const bf16x8*)(pw + (size_t)(16 * dt + fr) * 128 + 32 * s + 8 * fq);
            acc[dt] = __builtin_amdgcn_mfma_f32_16x16x32_bf16(af, bfrag, acc[dt], 0, 0, 0); }
        __builtin_amdgcn_sched_barrier(0);
    }
#pragma unroll
    for (int dt = 0; dt < 8; ++dt) { const int ch = gi * 128 + 16 * dt + 4 * fq;
        const f32x4 pb = *(const f32x4*)(poolb + l * BRW + ch), ps = *(const f32x4*)(pools + l * BRW + ch);
        const f32x4 y = (acc[dt] + pb) * ps;
        u32x2 w; w.x = cvt_pk_bf16(y[0], y[1]); w.y = cvt_pk_bf16(y[2], y[3]); *(u32x2*)(F.YS() + row * D + 1024 + ch) = w; }
}
__device__ __forceinline__ void conv_prompt_unit(const Frame& F, int l, int idx) {
    OPAQUE_IDS(F);
    const int b = idx >> 5, t0 = ((idx & 31) << 7) + 16 * wave;
    const size_t rowb = (size_t)b * SEQ;
    float w0[8], w1[8], w2[8];
    { const float* cw = inp(I_CONVW) + ((size_t)l * BRW + 8 * lane) * 3; float t[24];
#pragma unroll
        for (int i = 0; i < 6; ++i) { const f32x4 v = *(const f32x4*)(cw + 4 * i); t[4 * i] = v[0]; t[4 * i + 1] = v[1]; t[4 * i + 2] = v[2]; t[4 * i + 3] = v[3]; }
#pragma unroll
        for (int i = 0; i < 8; ++i) { w0[i] = t[3 * i]; w1[i] = t[3 * i + 1]; w2[i] = t[3 * i + 2]; } }
    float z2[8], z1[8];
#pragma unroll
    for (int i = 0; i < 8; ++i) { z2[i] = 0.f; z1[i] = 0.f; }
    for (int tt = t0 - 2; tt < t0 + 16; ++tt) {
        if (tt < 0) continue;
        const bf16_t* pr = F.P() + (rowb + tt) * NIN + 6144 + 8 * lane;
        float cg[8], hs[8], z[8]; unpack8(*(const u32x4*)(pr + 512), cg); unpack8(*(const u32x4*)(pr + 1024), hs);
#pragma unroll
        for (int i = 0; i < 8; ++i) z[i] = cg[i] * hs[i];
        if (tt >= t0) {
            float bg[8], y[8]; unpack8(*(const u32x4*)pr, bg);
#pragma unroll
            for (int i = 0; i < 8; ++i) y[i] = bg[i] * (z2[i] * w0[i] + z1[i] * w1[i] + z[i] * w2[i]);
            *(u32x4*)(F.YS() + (rowb + tt) * D + 1536 + 8 * lane) = pack8(y);
            if (tt >= SEQ - 2) { float* o = F.out + OUT_CONVP + ((size_t)((l * NBP + b) * 2 + (tt - (SEQ - 2)))) * BRW + 8 * lane;
                *(f32x4*)o = (f32x4){z[0], z[1], z[2], z[3]}; *(f32x4*)(o + 4) = (f32x4){z[4], z[5], z[6], z[7]}; }
        }
#pragma unroll
        for (int i = 0; i < 8; ++i) { z2[i] = z1[i]; z1[i] = z[i]; }
    }
}
__device__ __forceinline__ void attn_sample_unit(const Frame& F, int l, int idx) {
    OPAQUE_IDS(F);
    const int h = idx & 3, t = (idx >> 2) & 3, b = idx >> 4;
    LAS float* qs = (LAS float*)F.lds;
    LAS float* ps = qs + 384;
    LAS float* os = ps + 396;
    LAS float* ls = os + 384;
    const size_t prow = (size_t)(MP + b * TS + t);
    __syncthreads();
    if (wave < 3) {
        const int gi = wave, dsh = 2 * gi, wb = 128 << dsh;
        const int qcol = 1024 + gi * 1536 + h * 128, kcol = qcol + 512, vcol = qcol + 1024;
        { const unsigned qw = *(const unsigned*)(F.P() + prow * NIN + qcol + 2 * lane); qs[gi * 128 + 2 * lane] = bflo(qw); qs[gi * 128 + 2 * lane + 1] = bfhi(qw); }
        { float* ob = F.out + (gi == 0 ? OUT_B1S : (gi == 1 ? OUT_B2S : OUT_B3S)) + ((size_t)((l * NBS + b) * TS + t)) * 1024 + h * 128 + 2 * lane;
            const unsigned kw = *(const unsigned*)(F.P() + prow * NIN + kcol + 2 * lane), vw = *(const unsigned*)(F.P() + prow * NIN + vcol + 2 * lane);
            *(f32x2*)ob = (f32x2){bflo(kw), bfhi(kw)}; *(f32x2*)(ob + 512) = (f32x2){bflo(vw), bfhi(vw)}; }
        asm volatile("s_waitcnt lgkmcnt(0)" ::: "memory");
        const float* relb = inp(I_RELB);
        const float* cache = inp(I_CB1 + gi) + ((size_t)(l * NBS + b) * wb) * 1024;
        float lg[3]; float mx = -3.0e38f;
#pragma unroll
        for (int k3 = 0; k3 < 3; ++k3) { const int st = lane + 64 * k3; lg[k3] = -3.0e38f;
            if (st <= 128) { const int kidx = wb + t - (st << dsh); float dot = 0.f;
                if (kidx < wb) { const float* kp = cache + (size_t)kidx * 1024 + h * 128;
#pragma unroll 8
                    for (int e = 0; e < 128; e += 4) { const f32x4 kv = *(const f32x4*)(kp + e); const f32x4 qv = *(const LAS f32x4*)(qs + gi * 128 + e); dot += (kv[0] * qv[0] + kv[1] * qv[1]) + (kv[2] * qv[2] + kv[3] * qv[3]); } }
                else { const bf16_t* kp = F.P() + (size_t)(MP + b * TS + (kidx - wb)) * NIN + kcol;
#pragma unroll 4
                    for (int e = 0; e < 128; e += 8) { float kv[8]; unpack8(*(const u32x4*)(kp + e), kv);
#pragma unroll
                        for (int i = 0; i < 8; ++i) dot += kv[i] * qs[gi * 128 + e + i]; } }
                lg[k3] = dot * ATT_SCALE + relb[(int)BKT[gi][st] * 12 + gi * 4 + h]; mx = fmaxf(mx, lg[k3]); } }
        mx = wave_max(mx);
        float sum = 0.f;
#pragma unroll
        for (int k3 = 0; k3 < 3; ++k3) { const int st = lane + 64 * k3; if (st <= 128) { lg[k3] = __expf(lg[k3] - mx); sum += lg[k3]; } }
        sum = wave_sum(sum);
        const float inv = 1.0f / sum;
#pragma unroll
        for (int k3 = 0; k3 < 3; ++k3) { const int st = lane + 64 * k3; if (st <= 128) ps[gi * 132 + st] = lg[k3] * inv; }
        asm volatile("s_waitcnt lgkmcnt(0)" ::: "memory");
        float o0 = 0.f, o1 = 0.f;
        for (int st = 0; st <= 128; ++st) { const int kidx = wb + t - (st << dsh); const float p = ps[gi * 132 + st];
            if (kidx < wb) { const f32x2 v = *(const f32x2*)(cache + (size_t)kidx * 1024 + 512 + h * 128 + 2 * lane); o0 += p * v[0]; o1 += p * v[1]; }
            else { const unsigned vw = *(const unsigned*)(F.P() + (size_t)(MP + b * TS + (kidx - wb)) * NIN + vcol + 2 * lane); o0 += p * bflo(vw); o1 += p * bfhi(vw); } }
        os[gi * 128 + 2 * lane] = o0; os[gi * 128 + 2 * lane + 1] = o1;
        if (lane == 0) ls[gi] = mx + __logf(sum);
    }
    __syncthreads();
    if (tid < 128) { const float l0 = ls[0], l1 = ls[1], l2 = ls[2], m = fmaxf(l0, fmaxf(l1, l2)); const float e0 = __expf(l0 - m), e1 = __expf(l1 - m), e2 = __expf(l2 - m), inv = 1.0f / (e0 + e1 + e2);
        const float y = (e0 * os[tid] + e1 * os[128 + tid] + e2 * os[256 + tid]) * inv;
        F.YS()[prow * D + 512 + h * 128 + tid] = (bf16_t)f2bf(y); }
}
__device__ __forceinline__ void misc_sample_unit(const Frame& F, int l, int b) {
    OPAQUE_IDS(F);
    LAS float* red = (LAS float*)F.lds;
    LAS float* pl = red + 64;
    const size_t prow = (size_t)(MP + b * TS);
    __syncthreads();
    float vx[4], s4[4];
#pragma unroll
    for (int j = 0; j < 4; ++j) { vx[j] = bf1(F.P()[(prow + j) * NIN + 512 + tid]); s4[j] = wave_sum(vx[j]); }
    if (lane == 0) {
#pragma unroll
        for (int j = 0; j < 4; ++j) red[wave * 4 + j] = s4[j]; }
    __syncthreads();
    float mean[4];
#pragma unroll
    for (int j = 0; j < 4; ++j) { float s = 0.f;
#pragma unroll
        for (int w = 0; w < 8; ++w) s += red[w * 4 + j];
        mean[j] = s * (1.0f / BRW); vx[j] -= mean[j]; }
    __syncthreads();
#pragma unroll
    for (int j = 0; j < 4; ++j) s4[j] = wave_sum(vx[j] * vx[j]);
    if (lane == 0) {
#pragma unroll
        for (int j = 0; j < 4; ++j) red[wave * 4 + j] = s4[j]; }
    __syncthreads();
    const float lng = inp(I_ALNG)[l * BRW + tid], lnb = inp(I_ALNB)[l * BRW + tid];
    float v[4];
#pragma unroll
    for (int j = 0; j < 4; ++j) { float s = 0.f;
#pragma unroll
        for (int w = 0; w < 8; ++w) s += red[w * 4 + j];
        v[j] = vx[j] / sqrtf(s * (1.0f / BRW) + LN_EPS) * lng + lnb;
        F.out[OUT_CHUNKV + ((size_t)((l * NBS + b) * TS + j)) * BRW + tid] = v[j]; }
    { const int g = tid >> 7; const float* wsb = inp(I_AWS) + ((size_t)(l * 4 + g)) * 128 * 128; const float* absp = inp(I_ABS);
#pragma unroll
        for (int i = 0; i < 4; ++i) { float mix = absp[(l * 4 + g) * 128 + i];
#pragma unroll
            for (int j = 0; j < 4; ++j) if (j <= i) mix += wsb[i * 128 + j] * v[j];
            const float u = bf1(F.P()[(prow + i) * NIN + tid]);
            F.YS()[(prow + i) * D + tid] = (bf16_t)f2bf(u * mix); } }
    { const int gi = tid >> 7, win = 2 << gi; float full[19]; const float* cpool = inp(I_CPOOL);
#pragma unroll
        for (int k = 0; k < 15; ++k) full[k] = cpool[((size_t)((l * NBS + b) * 15 + k)) * BRW + tid];
#pragma unroll
        for (int j = 0; j < 4; ++j) { full[15 + j] = bf1(F.P()[(prow + j) * NIN + 5632 + tid]); F.out[OUT_POOLS + ((size_t)((l * NBS + b) * TS + j)) * BRW + tid] = full[15 + j]; }
#pragma unroll
        for (int j = 0; j < 4; ++j) { float s = 0.f;
#pragma unroll
            for (int k = 0; k < 16; ++k) if (k < win) s += full[15 + j - k];
            pl[j * BRW + tid] = s / (float)win - full[15 + j]; } }
    __syncthreads();
    { const int g = tid >> 7, d = tid & 127; const float* pw = inp(I_POOLW) + ((size_t)(l * 4 + g)) * 128 * 128 + d;
        float y[4] = {0.f, 0.f, 0.f, 0.f};
#pragma unroll 8
        for (int c = 0; c < 128; ++c) { const float w = pw[c * 128];
#pragma unroll
            for (int j = 0; j < 4; ++j) y[j] += pl[j * BRW + g * 128 + c] * w; }
        const float pb = inp(I_POOLB)[l * BRW + tid], psc = inp(I_POOLS)[l * BRW + tid];
#pragma unroll
        for (int j = 0; j < 4; ++j) F.YS()[(prow + j) * D + 1024 + tid] = (bf16_t)f2bf((y[j] + pb) * psc); }
    { const float* cvw = inp(I_CONVW) + ((size_t)l * BRW + tid) * 3; const float* ccv = inp(I_CCONV) + ((size_t)(l * NBS + b) * 2) * BRW + tid; const float w0 = cvw[0], w1 = cvw[1], w2 = cvw[2];
        float z2 = ccv[0], z1 = ccv[BRW];
#pragma unroll
        for (int j = 0; j < 4; ++j) { const bf16_t* pr = F.P() + (prow + j) * NIN + 6144 + tid; const float z = bf1(pr[512]) * bf1(pr[1024]);
            const float y = bf1(pr[0]) * (z2 * w0 + z1 * w1 + z * w2);
            F.YS()[(prow + j) * D + 1536 + tid] = (bf16_t)f2bf(y); F.out[OUT_CONVS + ((size_t)((l * NBS + b) * TS + j)) * BRW + tid] = z; z2 = z1; z1 = z; } }
}
constexpr int MX_SATT = 0, MX_SMISC = 128, MX_ATT = 136, MX_GMLP = 904, MX_POOL = 1160, MX_CONV = 1416, MX_END = 1480;
#ifndef UNIT_MASK
#define UNIT_MASK 0xFF
#endif
#define UON(k) (((UNIT_MASK) >> (k)) & 1)
__device__ __forceinline__ void mixer_phase(const Frame& F, int l) {
    for (int u = F.vcu; u < MX_END; u += F.G) {
        if (u < MX_SMISC) { if (UON(0)) attn_sample_unit(F, l, u); }
        else if (u < MX_ATT) { if (UON(1)) misc_sample_unit(F, l, u - MX_SMISC); }
        else if (u < MX_GMLP) { if (UON(2)) attn_prompt_unit(F, u - MX_ATT); }
        else if (u < MX_POOL) { if (UON(3)) gmlp_prompt_unit(F, l, u - MX_GMLP); }
        else if (u < MX_CONV) { if (UON(4)) pool_prompt_unit(F, l, u - MX_POOL); }
        else { if (UON(5)) conv_prompt_unit(F, l, u - MX_CONV); }
    }
}
__device__ __forceinline__ void combine_phase(const Frame& F, int l) {
    OPAQUE_IDS(F);
    const int gw = F.vcu * NWAVES + wave, NGW = F.G * NWAVES;
    for (int row = gw; row < MP; row += NGW) {
        const int h = lane >> 4;
        const float l0 = F.LSE()[((size_t)0 * MP + row) * 4 + h], l1 = F.LSE()[((size_t)1 * MP + row) * 4 + h], l2 = F.LSE()[((size_t)2 * MP + row) * 4 + h];
        const float m = fmaxf(l0, fmaxf(l1, l2)), e0 = __expf(l0 - m), e1 = __expf(l1 - m), e2 = __expf(l2 - m), inv = 1.0f / (e0 + e1 + e2);
        float a[8], c[8], y[8];
        unpack8(*(const u32x4*)(F.OG() + ((size_t)0 * MP + row) * BRW + 8 * lane), a);
#pragma unroll
        for (int i = 0; i < 8; ++i) y[i] = e0 * a[i];
        unpack8(*(const u32x4*)(F.OG() + ((size_t)1 * MP + row) * BRW + 8 * lane), c);
#pragma unroll
        for (int i = 0; i < 8; ++i) y[i] += e1 * c[i];
        unpack8(*(const u32x4*)(F.OG() + ((size_t)2 * MP + row) * BRW + 8 * lane), a);
#pragma unroll
        for (int i = 0; i < 8; ++i) y[i] = (y[i] + e2 * a[i]) * inv;
        *(u32x4*)(F.YS() + (size_t)row * D + 512 + 8 * lane) = pack8(y);
    }
    constexpr int NR = NBP * (128 + 512 + 2048);
    for (int it = gw; it < NR; it += NGW) {
        int gi, rem;
        if (it < NBP * 128) { gi = 0; rem = it; } else if (it < NBP * (128 + 512)) { gi = 1; rem = it - NBP * 128; } else { gi = 2; rem = it - NBP * (128 + 512); }
        const int keep = 128 << (2 * gi), b = rem / keep, rr = rem % keep;
        const bf16_t* src = F.P() + ((size_t)b * SEQ + SEQ - keep + rr) * NIN + 1024 + gi * 1536 + 512 + 16 * lane;
        float* dst = F.out + (gi == 0 ? OUT_B1P : (gi == 1 ? OUT_B2P : OUT_B3P)) + ((size_t)((l * NBP + b) * keep + rr)) * 1024 + 16 * lane;
        float a[8], c[8]; unpack8(*(const u32x4*)src, a); unpack8(*(const u32x4*)(src + 8), c);
        *(f32x4*)dst = (f32x4){a[0], a[1], a[2], a[3]}; *(f32x4*)(dst + 4) = (f32x4){a[4], a[5], a[6], a[7]};
        *(f32x4*)(dst + 8) = (f32x4){c[0], c[1], c[2], c[3]}; *(f32x4*)(dst + 12) = (f32x4){c[4], c[5], c[6], c[7]};
    }
    for (int it = gw; it < NBP * 15; it += NGW) { const int b = it / 15, rr = it % 15;
        float a[8]; unpack8(*(const u32x4*)(F.P() + ((size_t)b * SEQ + SEQ - 15 + rr) * NIN + 5632 + 8 * lane), a);
        float* dst = F.out + OUT_POOLP + ((size_t)((l * NBP + b) * 15 + rr)) * BRW + 8 * lane;
        *(f32x4*)dst = (f32x4){a[0], a[1], a[2], a[3]}; *(f32x4*)(dst + 4) = (f32x4){a[4], a[5], a[6], a[7]}; }
}

struct Args { const float* in[31]; float* out; unsigned char* ws; int ph_lo, ph_hi; };
constexpr int PH_PER_LAYER = 9, PH_FINAL = 2 + DEPTH * PH_PER_LAYER, N_PHASES = PH_FINAL + 1;

__global__ void __launch_bounds__(NTHREADS, 2) fwd_kernel(Args args) {
    extern __shared__ __attribute__((aligned(16))) unsigned char lds_raw[];
    Frame F;
    F.lds = (LAS unsigned char*)lds_raw;
    F.tid = threadIdx.x; F.lane = F.tid & 63; F.wave = __builtin_amdgcn_readfirstlane(F.tid >> 6);
    F.G = gridDim.x; { const int bx = blockIdx.x; F.vcu = (F.G % 8 == 0) ? (bx % 8) * (F.G / 8) + bx / 8 : bx; }
    F.out = args.out; F.ws = args.ws;
    unsigned char* ws = args.ws;

    volatile LAS unsigned* MISC = (volatile LAS unsigned*)(F.lds + MISC_OFF);
    for (int u = F.tid; u < (LDS_BYTES - LDSCTL_OFF) / 4; u += NTHREADS) ((LAS unsigned*)(F.lds + LDSCTL_OFF))[u] = 0u;
    __syncthreads();
    const int lo = args.ph_lo, hi = args.ph_hi;
    XcdBarrier bar; bar.bar = (unsigned*)(ws + WS_CTL) + CW_BAR; bar.x = 0; bar.st = nullptr;
    if (hi - lo > 1) bar = xcd_barrier_post((unsigned*)(ws + WS_CTL) + CW_BAR, MISC + 8);
#ifndef PHASE_MASK
#define PHASE_MASK 0xFFFF
#endif
#define ON(kind) (((PHASE_MASK) >> (kind)) & 1)
#define IN(k) (lo <= (k) && (k) < hi)
#define SEAM(k) do { if (IN(k) && IN((k) + 1)) xcd_barrier(bar); } while (0)

    if (ON(0) && IN(0)) { p0a_phase(F); } SEAM(0);
    if (ON(1) && IN(1)) { p0b_phase(F); } SEAM(1);
    for (int l = 0; l < DEPTH; ++l) {
        const int pb = 2 + l * PH_PER_LAYER;
        const float* modl = F.MOD() + (size_t)l * NBB * 6 * D;
        if (ON(2) && IN(pb + 0)) { norm_phase(F, modl, 1, 0); } SEAM(pb + 0);
        if (ON(3) && IN(pb + 1)) {
            pg8::Gemm g{F.HN(), (const bf16_t*)(ws + WS_BT1 + l * BT1_L), D, D, D}; pg8::StaticOrder S; S.init(MPAD / 256, N1 / 256, F.G, (int)blockIdx.x, D, D);
            pg8::Epi1 E{F.P(), F.GATES(), inp(I_BGATE) + (size_t)l * NGATE};
            pg8::gemm_phase<pg8::Epi1, pg8::StaticOrder>(F.lds, g, S, E);
        } SEAM(pb + 1);
        if (ON(4) && IN(pb + 2)) { mixer_phase(F, l); } SEAM(pb + 2);
        if (ON(5) && IN(pb + 3)) { combine_phase(F, l); } SEAM(pb + 3);
        if (ON(6) && IN(pb + 4)) {
            pg8::Gemm g{F.YS(), (const bf16_t*)(ws + WS_BT2 + l * BT2_L), D, BRW, BRW}; pg8::BranchOrder S{F.G, F.vcu, (MPAD / 256) * (D / 256)};
            pg8::Epi2 E{F.GATES(), F.MERGED(), F.ACC() + (size_t)F.vcu * (32 * 512 * 4)};
            pg8::gemm_phase<pg8::Epi2, pg8::BranchOrder>(F.lds, g, S, E);
        } SEAM(pb + 4);
        if (ON(7) && IN(pb + 5)) {
            pg8::Gemm g{F.MERGED(), (const bf16_t*)(ws + WS_BT3 + l * BT3_L), D, D, D}; pg8::StaticOrder S; S.init(MPAD / 256, D / 256, F.G, (int)blockIdx.x, D, D);
            pg8::EpiRes E{F.X(), modl, 2};
            pg8::gemm_phase<pg8::EpiRes, pg8::StaticOrder>(F.lds, g, S, E);
        } SEAM(pb + 5);
        if (ON(8) && IN(pb + 6)) { norm_phase(F, modl, 4, 3); } SEAM(pb + 6);
        if (ON(9) && IN(pb + 7)) {
            pg8::Gemm g{F.HN(), (const bf16_t*)(ws + WS_BT4 + l * BT4_L), D, D, D}; pg8::StaticOrder S; S.init(MPAD / 256, N4 / 256, F.G, (int)blockIdx.x, D, D);
            pg8::EpiSwi E{F.H()};
            pg8::gemm_phase<pg8::EpiSwi, pg8::StaticOrder>(F.lds, g, S, E);
        } SEAM(pb + 7);
        if (ON(10) && IN(pb + 8)) {
            pg8::Gemm g{F.H(), (const bf16_t*)(ws + WS_BT5 + l * BT5_L), DFF, DFF, DFF}; pg8::StaticOrder S; S.init(MPAD / 256, D / 256, F.G, (int)blockIdx.x, DFF, DFF);
            pg8::EpiRes E{F.X(), modl, 5};
            pg8::gemm_phase<pg8::EpiRes, pg8::StaticOrder>(F.lds, g, S, E);
        } SEAM(pb + 8);
    }
    if (ON(11) && IN(PH_FINAL)) { final_norm_phase(F); }
#undef IN
#undef SEAM
}

extern "C" void kernel_launch(void* const* d_in, const int* in_sizes, int n_in, void* d_out, int out_size, void* d_ws, size_t ws_size, hipStream_t stream) {
    static int grid = 0;
    if (grid == 0) {
        if (n_in != 31 || (size_t)out_size != OUT_END || ws_size < WS_END) { fprintf(stderr, "kernel_launch: unexpected problem (n_in %d, out %d, ws %zu)\n", n_in, out_size, ws_size); grid = -1; return; }
        int dev = 0, cus = 0, per_cu = 0;
        if (hipGetDevice(&dev) != hipSuccess || hipDeviceGetAttribute(&cus, hipDeviceAttributeMultiprocessorCount, dev) != hipSuccess) { grid = -1; return; }
        if (hipFuncSetAttribute((const void*)fwd_kernel, hipFuncAttributeMaxDynamicSharedMemorySize, LDS_BYTES) != hipSuccess) { fprintf(stderr, "kernel_launch: hipFuncSetAttribute failed\n"); grid = -1; return; }
        if (hipOccupancyMaxActiveBlocksPerMultiprocessor(&per_cu, (const void*)fwd_kernel, NTHREADS, LDS_BYTES) != hipSuccess || per_cu < 1) fprintf(stderr, "kernel_launch: occupancy query reports %d\n", per_cu);
        (void)hipGetLastError();
        grid = cus < 256 ? cus : 256;
    }
    if (grid < 0) return;
    if (hipMemsetAsync((char*)d_ws + WS_CTL, 0, CTL_ZERO_BYTES, stream) != hipSuccess) return;
    Args a{};
    for (int i = 0; i < 31; ++i) a.in[i] = (const float*)d_in[i];
    a.out = (float*)d_out; a.ws = (unsigned char*)d_ws;
#if MK_MULTI_LAUNCH
    for (int ph = 0; ph < N_PHASES; ++ph) { a.ph_lo = ph; a.ph_hi = ph + 1; hipLaunchKernelGGL(fwd_kernel, dim3(grid), dim3(NTHREADS), LDS_BYTES, stream, a); }
#else
    a.ph_lo = 0; a.ph_hi = N_PHASES; hipLaunchKernelGGL(fwd_kernel, dim3(grid), dim3(NTHREADS), LDS_BYTES, stream, a);
#endif
}
```

```cpp
#include <hip/hip_runtime.h>
#include <cstdio>
#include <cstdint>

#ifndef MK_MULTI_LAUNCH
#define MK_MULTI_LAUNCH 0
#endif

#define LAS __attribute__((address_space(3)))
#define GAS __attribute__((address_space(1)))
typedef unsigned short bf16_t;
typedef short bf16x8 __attribute__((ext_vector_type(8)));
typedef float f32x4 __attribute__((ext_vector_type(4)));
typedef float f32x2 __attribute__((ext_vector_type(2)));
typedef unsigned u32x4 __attribute__((ext_vector_type(4)));
typedef unsigned u32x2 __attribute__((ext_vector_type(2)));

constexpr int D = 2048, SEQ = 4096, NBP = 2, MP = NBP * SEQ, NBS = 8, TS = 4, MS = NBS * TS, MREAL = MP + MS, MPAD = 8448;
constexpr int NIN = 7680, NGATE = 8192, N1 = NIN + NGATE, DFF = 5632, N4 = 2 * DFF, BRW = 512, DEPTH = 4, NBB = NBP + NBS;
constexpr int NWAVES = 8, NTHREADS = 512;
constexpr float RMS_EPS = 1e-6f, LN_EPS = 1e-5f;
constexpr float ATT_SCALE = 0.08838834764831845f;

constexpr size_t OUT_Y = 0;
constexpr size_t OUT_B1P = (size_t)MREAL * D;
constexpr size_t OUT_B2P = OUT_B1P + (size_t)DEPTH * NBP * 128 * 1024;
constexpr size_t OUT_B3P = OUT_B2P + (size_t)DEPTH * NBP * 512 * 1024;
constexpr size_t OUT_POOLP = OUT_B3P + (size_t)DEPTH * NBP * 2048 * 1024;
constexpr size_t OUT_CONVP = OUT_POOLP + (size_t)DEPTH * NBP * 15 * 512;
constexpr size_t OUT_B1S = OUT_CONVP + (size_t)DEPTH * NBP * 2 * 512;
constexpr size_t OUT_B2S = OUT_B1S + (size_t)DEPTH * NBS * TS * 1024;
constexpr size_t OUT_B3S = OUT_B2S + (size_t)DEPTH * NBS * TS * 1024;
constexpr size_t OUT_POOLS = OUT_B3S + (size_t)DEPTH * NBS * TS * 1024;
constexpr size_t OUT_CONVS = OUT_POOLS + (size_t)DEPTH * NBS * TS * 512;
constexpr size_t OUT_CHUNKV = OUT_CONVS + (size_t)DEPTH * NBS * TS * 512;
constexpr size_t OUT_END = OUT_CHUNKV + (size_t)DEPTH * NBS * TS * 512;
static_assert(OUT_END == 39522304, "output size");

constexpr size_t MiB = 1u << 20;
constexpr size_t WS_CTL = 0, CTL_ZERO_BYTES = 1 * MiB;
constexpr size_t WS_MOD = 1 * MiB;
constexpr size_t WS_MODP = 3 * MiB;
constexpr size_t WS_POOLWT = 33 * MiB;
constexpr size_t WS_BT1 = 34 * MiB, BT1_L = (size_t)N1 * D * 2;
constexpr size_t WS_BT2 = 282 * MiB, BT2_L = (size_t)4 * D * BRW * 2;
constexpr size_t WS_BT3 = 314 * MiB, BT3_L = (size_t)D * D * 2;
constexpr size_t WS_BT4 = 346 * MiB, BT4_L = (size_t)N4 * D * 2;
constexpr size_t WS_BT5 = 522 * MiB, BT5_L = (size_t)D * DFF * 2;
constexpr size_t WS_X = 610 * MiB;
constexpr size_t WS_HN = 676 * MiB;
constexpr size_t WS_P = 709 * MiB;
constexpr size_t WS_GATES = 833 * MiB;
constexpr size_t WS_YS = 965 * MiB;
constexpr size_t WS_OG = 998 * MiB;
constexpr size_t WS_LSE = 1022 * MiB;
constexpr size_t WS_MERGED = 1023 * MiB;
constexpr size_t WS_ACC = 1056 * MiB;
constexpr size_t WS_H = 1120 * MiB;
constexpr size_t WS_END = 1211 * MiB;
static_assert(WS_BT1 + 4 * BT1_L <= WS_BT2 && WS_BT2 + 4 * BT2_L <= WS_BT3 && WS_BT3 + 4 * BT3_L <= WS_BT4 && WS_BT4 + 4 * BT4_L <= WS_BT5 && WS_BT5 + 4 * BT5_L <= WS_X, "ws map (weights)");
static_assert(WS_X + (size_t)MPAD * D * 4 <= WS_HN && WS_HN + (size_t)MPAD * D * 2 <= WS_P && WS_P + (size_t)MPAD * NIN * 2 <= WS_GATES && WS_GATES + (size_t)MPAD * NGATE * 2 <= WS_YS, "ws map (act 1)");
static_assert(WS_YS + (size_t)MPAD * D * 2 <= WS_OG && WS_OG + (size_t)3 * MP * BRW * 2 <= WS_LSE && WS_LSE + (size_t)3 * MP * 4 * 4 <= WS_MERGED && WS_MERGED + (size_t)MPAD * D * 2 <= WS_ACC, "ws map (act 2)");
static_assert(WS_ACC + (size_t)256 * 32 * 512 * 16 <= WS_H && WS_H + (size_t)MPAD * DFF * 2 <= WS_END, "ws map (act 3)");
static_assert(WS_MOD + (size_t)DEPTH * NBB * 6 * D * 4 <= WS_MODP && WS_MODP + (size_t)16 * DEPTH * NBB * 6 * D * 4 <= WS_POOLWT, "ws map (mod)");
constexpr int CW_BAR = 4096;

constexpr int RING_BYTES = 131072;
constexpr int LDSCTL_OFF = RING_BYTES, MISC_OFF = LDSCTL_OFF + 320;
constexpr int LDS_BYTES = 147456;

__device__ __forceinline__ unsigned cvt_pk_bf16(float lo, float hi) { unsigned r; asm("v_cvt_pk_bf16_f32 %0, %1, %2" : "=v"(r) : "v"(lo), "v"(hi)); return r; }
__device__ __forceinline__ float bflo(unsigned u) { return __uint_as_float(u << 16); }
__device__ __forceinline__ float bfhi(unsigned u) { return __uint_as_float(u & 0xffff0000u); }
__device__ __forceinline__ float bf1(bf16_t b) { return __uint_as_float(((unsigned)b) << 16); }
__device__ __forceinline__ void unpack8(const u32x4 w, float (&f)[8]) { f[0] = bflo(w.x); f[1] = bfhi(w.x); f[2] = bflo(w.y); f[3] = bfhi(w.y); f[4] = bflo(w.z); f[5] = bfhi(w.z); f[6] = bflo(w.w); f[7] = bfhi(w.w); }
__device__ __forceinline__ u32x4 pack8(const float (&f)[8]) { u32x4 w; w.x = cvt_pk_bf16(f[0], f[1]); w.y = cvt_pk_bf16(f[2], f[3]); w.z = cvt_pk_bf16(f[4], f[5]); w.w = cvt_pk_bf16(f[6], f[7]); return w; }
__device__ __forceinline__ float wave_sum(float v) {
#pragma unroll
    for (int o = 1; o < 64; o <<= 1) v += __shfl_xor(v, o);
    return v;
}
__device__ __forceinline__ float wave_max(float v) {
#pragma unroll
    for (int o = 1; o < 64; o <<= 1) v = fmaxf(v, __shfl_xor(v, o));
    return v;
}
__device__ __forceinline__ float sigmoidf_(float x) { return 1.0f / (1.0f + __expf(-x)); }
__device__ __forceinline__ float gelu_tanh(float x) { const float u = 0.7978845608028654f * (x + 0.044715f * x * x * x); return x / (1.0f + __expf(-2.0f * u)); }

__constant__ unsigned char BKT[3][132] = {
{0,1,2,3,4,5,6,7,8,9,10,11,12,13,14,15,16,16,16,16,16,16,17,17,17,17,17,17,17,17,18,18,18,18,18,18,18,18,18,18,19,19,19,19,19,19,19,19,19,19,19,19,19,19,20,20,20,20,20,20,20,20,20,20,20,20,20,20,20,20,20,20,20,21,21,21,21,21,21,21,21,21,21,21,21,21,21,21,21,21,21,21,21,21,21,21,21,21,21,22,22,22,22,22,22,22,22,22,22,22,22,22,22,22,22,22,22,22,22,22,22,22,22,22,22,22,22,22,22,0,0,0},
{0,4,8,12,16,16,17,17,18,18,19,19,19,19,20,20,20,20,20,21,21,21,21,21,21,22,22,22,22,22,22,22,22,22,23,23,23,23,23,23,23,23,23,23,23,23,24,24,24,24,24,24,24,24,24,24,24,24,24,24,24,24,25,25,25,25,25,25,25,25,25,25,25,25,25,25,25,25,25,25,25,25,25,26,26,26,26,26,26,26,26,26,26,26,26,26,26,26,26,26,26,26,26,26,26,26,26,26,26,26,26,26,26,27,27,27,27,27,27,27,27,27,27,27,27,27,27,27,27,0,0,0},
{0,16,18,19,20,21,21,22,22,23,23,23,24,24,24,24,25,25,25,25,25,26,26,26,26,26,26,26,26,27,27,27,27,27,27,27,27,27,27,28,28,28,28,28,28,28,28,28,28,28,28,28,29,29,29,29,29,29,29,29,29,29,29,29,29,29,29,29,29,29,30,30,30,30,30,30,30,30,30,30,30,30,30,30,30,30,30,30,30,30,30,30,30,30,30,31,31,31,31,31,31,31,31,31,31,31,31,31,31,31,31,31,31,31,31,31,31,31,31,31,31,31,31,31,31,31,31,31,31,0,0,0}};

#define XB_TMO      128
#define XB_XCNT(j)  (256  + 64 * (j))
#define XB_XSUB(j)  (1280 + 64 * (j))
#define XB_XGEN(j)  (2304 + 64 * (j))
#define XB_TOP      3328
#define XB_TOPGEN   3392
#define XCD_BAR_WORDS 3456
#define XB_SPIN_CAP (1u << 18)
__device__ __forceinline__ unsigned xb_ld(unsigned* p)              { return __hip_atomic_load(p, __ATOMIC_RELAXED, __HIP_MEMORY_SCOPE_AGENT); }
__device__ __forceinline__ unsigned xb_add(unsigned* p, unsigned v) { return __hip_atomic_fetch_add(p, v, __ATOMIC_RELAXED, __HIP_MEMORY_SCOPE_AGENT); }
__device__ __forceinline__ unsigned xb_xcc_id() { return (unsigned)__builtin_amdgcn_s_getreg((3 << 11) | 20) & 0xFu; }
#define XB_SPIN(cond, bar) do { unsigned _sp = 0; while (cond) { __builtin_amdgcn_s_sleep(1); \
    if ((++_sp & 255u) == 0u) { if (xb_ld(&(bar)[XB_TMO])) break; if (_sp > XB_SPIN_CAP) { atomicAdd(&(bar)[XB_TMO], 1u); break; } } } } while (0)
struct XcdBarrier { unsigned* bar; unsigned x; volatile LAS unsigned* st; };
__device__ __forceinline__ XcdBarrier xcd_barrier_post(unsigned* bar, volatile LAS unsigned* st) {
    XcdBarrier b; b.bar = bar; b.x = xb_xcc_id(); b.st = st;
    if (threadIdx.x == 0) (void)xb_add(&bar[XB_XCNT(b.x)], 1u);
    return b;
}
__device__ __forceinline__ void xcd_barrier_complete(unsigned* bar, unsigned x, unsigned& nloc, unsigned& nx) {
    const unsigned G = gridDim.x * gridDim.y * gridDim.z;
    unsigned sum, cnt, mine, sp = 0u;
    for (;;) {
        sum = 0u; cnt = 0u; mine = 0u;
#pragma unroll
        for (unsigned j = 0; j < 16; ++j) { const unsigned c = xb_ld(&bar[XB_XCNT(j)]); sum += c; cnt += (c > 0u) ? 1u : 0u; mine = (j == x) ? c : mine; }
        if (sum == G) break;
        __builtin_amdgcn_s_sleep(1);
        if ((++sp & 255u) == 0u) { if (xb_ld(&bar[XB_TMO])) break; if (sp > XB_SPIN_CAP) { atomicAdd(&bar[XB_TMO], 1u); break; } }
    }
    nloc = mine > 0u ? mine : 1u; nx = cnt > 0u ? cnt : 1u;
}
__device__ __forceinline__ void xcd_barrier(const XcdBarrier& b) {
    asm volatile("s_waitcnt vmcnt(0)" ::: "memory");
    __syncthreads();
    if (threadIdx.x == 0) {
        unsigned* bar = b.bar;
        __builtin_amdgcn_s_waitcnt(0);
        unsigned nloc = b.st[0], nx = b.st[1];
        if (nloc == 0u) { xcd_barrier_complete(bar, b.x, nloc, nx); b.st[0] = nloc; b.st[1] = nx; }
        const unsigned old = xb_add(&bar[XB_XSUB(b.x)], 1u);
        const unsigned gen = old / nloc;
        if (old + 1u == (gen + 1u) * nloc) {
            __builtin_amdgcn_fence(__ATOMIC_RELEASE, "agent");
            asm volatile("s_waitcnt vmcnt(0)" ::: "memory");
            const unsigned og = xb_add(&bar[XB_TOP], 1u);
            const unsigned tg = og / nx;
            if (og + 1u == (tg + 1u) * nx) xb_add(&bar[XB_TOPGEN], 1u);
            else XB_SPIN(xb_ld(&bar[XB_TOPGEN]) == tg, bar);
            __builtin_amdgcn_fence(__ATOMIC_ACQUIRE, "agent");
            xb_add(&bar[XB_XGEN(b.x)], 1u);
            asm volatile("s_waitcnt vmcnt(0)" ::: "memory");
        } else {
            XB_SPIN(xb_ld(&bar[XB_XGEN(b.x)]) == gen, bar);
            __builtin_amdgcn_fence(__ATOMIC_ACQUIRE, "agent");
            asm volatile("s_waitcnt vmcnt(0)" ::: "memory");
        }
    }
    __syncthreads();
}

namespace pg8 {
constexpr int BM = 256, BK = 64, HALF = 128, HTB = HALF * BK * 2, STAGE_BYTES = 8 * HTB, NXCD = 8, WGM = 8;
__host__ __device__ __forceinline__ int lds_byte(int r, int c) { const int st = (r >> 4) * 2 + (c >> 5), rr = r & 15, cc = c & 31, ob = rr * 64 + cc * 2; return st * 1024 + (ob ^ (((ob >> 9) & 1) << 5)); }
__host__ __device__ __forceinline__ void stage_rc(int b, int& R, int& C) { const int st = b / 1024, sb = b % 1024, swz = sb ^ (((sb >> 9) & 1) << 5); R = (st >> 1) * 16 + swz / 64; C = (st & 1) * 32 + (swz % 64) / 2; }
__host__ __device__ __forceinline__ int perm32(int rho) { const int n = rho >> 4, i = rho & 15; return 8 * (i >> 2) + 4 * n + (i & 3); }

struct Unit { int pm, pn, tag; size_t aoff, boff; };
struct Gemm { const bf16_t* A; const bf16_t* Bt; int lda, ldb, K; };

struct StaticOrder {
    int nM, nN, nwg, G, c; size_t astep, bstep;
    __device__ void init(int nM_, int nN_, int G_, int c_, int lda, int ldb) { nM = nM_; nN = nN_; nwg = nM * nN; G = G_; c = c_; astep = (size_t)BM * lda * 2; bstep = (size_t)BM * ldb * 2; }
    __device__ bool next(int i, Unit& u) const {
        const long L = (long)i * G + c; if (L >= nwg) return false;
        int wgid = (int)L; { const int q = nwg / NXCD, r = nwg % NXCD, xcd = wgid % NXCD, off = wgid / NXCD; wgid = (xcd < r ? xcd * (q + 1) : r * (q + 1) + (xcd - r) * q) + off; }
        const int nig = WGM * nN, gid = wgid / nig, fm = gid * WGM, gsz = (nM - fm) < WGM ? (nM - fm) : WGM;
        u.pm = fm + ((wgid % nig) % gsz); u.pn = (wgid % nig) / gsz; u.tag = 0; u.aoff = (size_t)u.pm * astep; u.boff = (size_t)u.pn * bstep; return true;
    }
};
struct BranchOrder {
    int G, vc, ntiles;
    __device__ bool next(int i, Unit& u) const {
        const int T = vc + G * (i >> 2); if (T >= ntiles) return false;
        const int g = i & 3; u.pm = T >> 3; u.pn = T & 7; u.tag = g;
        u.aoff = ((size_t)u.pm * BM * D + (size_t)g * BRW) * 2; u.boff = ((size_t)g * D + (size_t)u.pn * BM) * BRW * 2; return true;
    }
};

template <class Epi, class Sched>
__device__ __forceinline__ void gemm_phase(LAS unsigned char* lds, const Gemm g, const Sched& S, const Epi& E) {
    int lane = threadIdx.x & 63, wid = __builtin_amdgcn_readfirstlane(threadIdx.x >> 6); asm volatile("" : "+v"(lane)); asm volatile("" : "+s"(wid));
    const int tid = wid * 64 + lane, wr = wid >> 2, wc = wid & 3, fr = lane & 15, fq = lane >> 4;
    const int K = g.K, nt = K / BK;
    unsigned voffA[2], voffB[2];
#pragma unroll
    for (int i = 0; i < 2; ++i) { int R, C; stage_rc(tid * 16 + i * 8192, R, C); const int Rb = Epi::PERM ? ((R & ~31) + perm32(R & 31)) : R;
        voffA[i] = (unsigned)(R * g.lda + C) * 2u; voffB[i] = (unsigned)(Rb * g.ldb + C) * 2u; }
    const size_t kstep = (size_t)(BK * 2);
    const size_t hA = (size_t)HALF * g.lda * 2, hB = (size_t)HALF * g.ldb * 2;
    const unsigned ldsw = (unsigned)wid * 1024u;
    const int aoff = lds_byte(wr * 64 + fr, fq * 8), boff = lds_byte(wc * 32 + fr, fq * 8);
#define PG8_SA(b, h) (((b) * 2 + (h)) * HTB)
#define PG8_SB(b, h) ((4 + (b) * 2 + (h)) * HTB)
#define PG8_STAGE(bufoff, gbase, voff) do { _Pragma("unroll") for (int _i = 0; _i < 2; ++_i) \
        __builtin_amdgcn_global_load_lds((const unsigned*)((const char*)(gbase) + (voff)[_i]), (LAS unsigned*)(lds + (bufoff) + ldsw + _i * 8192), 16, 0, 0); } while (0)
#define PG8_LDA(dst, b, h) do { _Pragma("unroll") for (int m = 0; m < 4; ++m) _Pragma("unroll") for (int k = 0; k < 2; ++k) dst[m][k] = *(const LAS bf16x8*)(lds + PG8_SA(b, h) + aoff + m * 2048 + k * 1024); } while (0)
#define PG8_LDB(dst, b, h) do { _Pragma("unroll") for (int n = 0; n < 2; ++n) _Pragma("unroll") for (int k = 0; k < 2; ++k) dst[n][k] = *(const LAS bf16x8*)(lds + PG8_SB(b, h) + boff + n * 2048 + k * 1024); } while (0)
#define PG8_MMA(ai, bj, At, Bt) do { __builtin_amdgcn_s_setprio(1); _Pragma("unroll") for (int m = 0; m < 4; ++m) _Pragma("unroll") for (int n = 0; n < 2; ++n) _Pragma("unroll") for (int k = 0; k < 2; ++k) \
        acc[ai][bj][m][n] = __builtin_amdgcn_mfma_f32_16x16x32_bf16(Bt[n][k], At[m][k], acc[ai][bj][m][n], 0, 0, 0); __builtin_amdgcn_s_setprio(0); } while (0)
#define PG8_WAIT_V(n) asm volatile("s_waitcnt vmcnt(" #n ")" ::: "memory")
#define PG8_WAIT_L(n) asm volatile("s_waitcnt lgkmcnt(" #n ")" ::: "memory")
#define PG8_BAR __builtin_amdgcn_s_barrier()
#define PG8_SCHED __builtin_amdgcn_sched_barrier(0)
    Unit cur, nxt; int ui = 0;
    if (!S.next(0, cur)) return;
    f32x4 acc[2][2][4][2];
#pragma unroll
    for (int a = 0; a < 2; ++a)
#pragma unroll
        for (int b = 0; b < 2; ++b)
#pragma unroll
            for (int m = 0; m < 4; ++m)
#pragma unroll
                for (int n = 0; n < 2; ++n) acc[a][b][m][n] = (f32x4){0.f, 0.f, 0.f, 0.f};
    bf16x8 At[4][2], B0[2][2], B1[2][2];
    const char* cA = (const char*)g.A + cur.aoff; const char* cB = (const char*)g.Bt + cur.boff;
    PG8_STAGE(PG8_SB(0, 0), cB, voffB); PG8_STAGE(PG8_SB(0, 1), cB + hB, voffB); PG8_STAGE(PG8_SA(0, 0), cA, voffA); PG8_STAGE(PG8_SA(0, 1), cA + hA, voffA);
    if (wr == 1) PG8_BAR;
    PG8_WAIT_V(2); PG8_BAR;
    PG8_STAGE(PG8_SB(1, 0), cB + kstep, voffB); PG8_STAGE(PG8_SA(1, 0), cA + kstep, voffA); PG8_STAGE(PG8_SB(1, 1), cB + hB + kstep, voffB);
    PG8_WAIT_V(6); PG8_BAR;
    for (;;) {
        const bool has_next = S.next(ui + 1, nxt);
        const char* nA = has_next ? (const char*)g.A + nxt.aoff : cA; const char* nB = has_next ? (const char*)g.Bt + nxt.boff : cB;
        for (int t = 0; t < nt; t += 2) {
            const bool last = (t == nt - 2);
            const char* a1 = cA + (size_t)(t + 1) * kstep;
            const char* a2 = last ? nA : cA + (size_t)(t + 2) * kstep; const char* b2 = last ? nB : cB + (size_t)(t + 2) * kstep;
            const char* a3 = a2 + kstep; const char* b3 = b2 + kstep;
            PG8_LDB(B0, 0, 0); PG8_LDB(B1, 0, 1); PG8_SCHED; PG8_LDA(At, 0, 0); PG8_STAGE(PG8_SA(1, 1), a1 + hA, voffA);
            PG8_WAIT_V(8); PG8_WAIT_L(0); PG8_BAR; PG8_MMA(0, 0, At, B0); PG8_MMA(0, 1, At, B1); PG8_BAR; PG8_SCHED;
            PG8_LDA(At, 0, 1); PG8_STAGE(PG8_SB(0, 0), b2, voffB); PG8_STAGE(PG8_SB(0, 1), b2 + hB, voffB); PG8_STAGE(PG8_SA(0, 0), a2, voffA);
            PG8_WAIT_V(8); PG8_WAIT_L(0); PG8_BAR; PG8_MMA(1, 0, At, B0); PG8_MMA(1, 1, At, B1); PG8_BAR; PG8_SCHED;
            PG8_LDB(B0, 1, 0); PG8_LDB(B1, 1, 1); PG8_SCHED; PG8_LDA(At, 1, 0); PG8_STAGE(PG8_SA(0, 1), a2 + hA, voffA);
            PG8_WAIT_V(8); PG8_WAIT_L(0); PG8_BAR; PG8_MMA(0, 0, At, B0); PG8_MMA(0, 1, At, B1); PG8_BAR; PG8_SCHED;
            PG8_LDA(At, 1, 1); PG8_STAGE(PG8_SB(1, 0), b3, voffB); PG8_STAGE(PG8_SB(1, 1), b3 + hB, voffB); PG8_STAGE(PG8_SA(1, 0), a3, voffA);
            PG8_WAIT_V(8); PG8_WAIT_L(0); PG8_BAR; PG8_MMA(1, 0, At, B0); PG8_MMA(1, 1, At, B1); PG8_BAR; PG8_SCHED;
        }
        if (wr == 0) PG8_BAR;
        E(acc, cur, wr, wc, fr, fq);
        if (!has_next) break;
#pragma unroll
        for (int a = 0; a < 2; ++a)
#pragma unroll
            for (int b = 0; b < 2; ++b)
#pragma unroll
                for (int m = 0; m < 4; ++m)
#pragma unroll
                    for (int n = 0; n < 2; ++n) acc[a][b][m][n] = (f32x4){0.f, 0.f, 0.f, 0.f};
        cur = nxt; cA = nA; cB = nB; ++ui;
        if (wr == 1) PG8_BAR;
    }
    PG8_WAIT_V(0);
    PG8_BAR;
#undef PG8_SA
#undef PG8_SB
#undef PG8_STAGE
#undef PG8_LDA
#undef PG8_LDB
#undef PG8_MMA
#undef PG8_WAIT_V
#undef PG8_WAIT_L
#undef PG8_BAR
#undef PG8_SCHED
}

struct Epi1 {
    static constexpr bool PERM = true;
    bf16_t* P; bf16_t* G; const float* bg;
    __device__ __forceinline__ void operator()(const f32x4 (&acc)[2][2][4][2], const Unit& u, int wr, int wc, int fr, int fq) const {
        const int row0 = u.pm * BM + wr * 64 + fr, ct = u.pn * BM, cw = wc * 32 + 8 * fq;
        if (ct < NIN) {
            const bool gelu = ct < 1024;
#pragma unroll
            for (int ai = 0; ai < 2; ++ai)
#pragma unroll
                for (int m = 0; m < 4; ++m) { bf16_t* rowp = P + (size_t)(row0 + ai * HALF + m * 16) * NIN + ct + cw;
#pragma unroll
                    for (int bj = 0; bj < 2; ++bj) { f32x4 v0 = acc[ai][bj][m][0], v1 = acc[ai][bj][m][1];
                        if (gelu) {
#pragma unroll
                            for (int j = 0; j < 4; ++j) { v0[j] = gelu_tanh(v0[j]); v1[j] = gelu_tanh(v1[j]); } }
                        u32x4 w; w.x = cvt_pk_bf16(v0[0], v0[1]); w.y = cvt_pk_bf16(v0[2], v0[3]); w.z = cvt_pk_bf16(v1[0], v1[1]); w.w = cvt_pk_bf16(v1[2], v1[3]);
                        *(u32x4*)(rowp + bj * HALF) = w; } }
        } else {
            const int cg = ct - NIN + cw;
            f32x4 bv[2][2];
#pragma unroll
            for (int bj = 0; bj < 2; ++bj)
#pragma unroll
                for (int n = 0; n < 2; ++n) bv[bj][n] = *(const f32x4*)(bg + cg + bj * HALF + 4 * n);
#pragma unroll
            for (int ai = 0; ai < 2; ++ai)
#pragma unroll
                for (int m = 0; m < 4; ++m) { bf16_t* rowp = G + (size_t)(row0 + ai * HALF + m * 16) * NGATE + cg;
#pragma unroll
                    for (int bj = 0; bj < 2; ++bj) { f32x4 v0 = acc[ai][bj][m][0] + bv[bj][0], v1 = acc[ai][bj][m][1] + bv[bj][1];
#pragma unroll
                        for (int j = 0; j < 4; ++j) { v0[j] = sigmoidf_(v0[j]); v1[j] = sigmoidf_(v1[j]); }
                        u32x4 w; w.x = cvt_pk_bf16(v0[0], v0[1]); w.y = cvt_pk_bf16(v0[2], v0[3]); w.z = cvt_pk_bf16(v1[0], v1[1]); w.w = cvt_pk_bf16(v1[2], v1[3]);
                        *(u32x4*)(rowp + bj * HALF) = w; } }
        }
    }
};
struct Epi2 {
    static constexpr bool PERM = true;
    const bf16_t* G; bf16_t* O; float* slab;
    __device__ __forceinline__ void operator()(const f32x4 (&acc)[2][2][4][2], const Unit& u, int wr, int wc, int fr, int fq) const {
        const int g = u.tag, row0 = u.pm * BM + wr * 64 + fr, cw = u.pn * BM + wc * 32 + 8 * fq;
        float* sl = slab + (size_t)threadIdx.x * 4; asm volatile("" : "+v"(sl));
#pragma unroll
        for (int ai = 0; ai < 2; ++ai)
#pragma unroll
            for (int m = 0; m < 4; ++m) { const size_t row = (size_t)(row0 + ai * HALF + m * 16);
#pragma unroll
                for (int bj = 0; bj < 2; ++bj) {
                    const u32x4 gw = *(const u32x4*)(G + row * NGATE + (size_t)g * D + cw + bj * HALF);
                    f32x4 v0 = acc[ai][bj][m][0] * (f32x4){bflo(gw.x), bfhi(gw.x), bflo(gw.y), bfhi(gw.y)};
                    f32x4 v1 = acc[ai][bj][m][1] * (f32x4){bflo(gw.z), bfhi(gw.z), bflo(gw.w), bfhi(gw.w)};
                    float* s0 = sl + (size_t)((((ai * 4 + m) * 2 + bj) * 2 + 0) * 2048), *s1 = s0 + 2048;
                    if (g > 0) { v0 += *(const f32x4*)s0; v1 += *(const f32x4*)s1; }
                    if (g < 3) { *(f32x4*)s0 = v0; *(f32x4*)s1 = v1; }
                    else { u32x4 w; w.x = cvt_pk_bf16(v0[0], v0[1]); w.y = cvt_pk_bf16(v0[2], v0[3]); w.z = cvt_pk_bf16(v1[0], v1[1]); w.w = cvt_pk_bf16(v1[2], v1[3]);
                        *(u32x4*)(O + row * D + cw + bj * HALF) = w; } }
                asm volatile("" ::: "memory"); }
    }
};
struct EpiRes {
    static constexpr bool PERM = false;
    float* X; const float* modl; int jg;
    __device__ __forceinline__ void operator()(const f32x4 (&acc)[2][2][4][2], const Unit& u, int wr, int wc, int fr, int fq) const {
        const int row0 = u.pm * BM + wr * 64 + fr, col0 = u.pn * BM + wc * 32 + 4 * fq;
#pragma unroll
        for (int ai = 0; ai < 2; ++ai)
#pragma unroll
            for (int m = 0; m < 4; ++m) { const int row = row0 + ai * HALF + m * 16;
                int bb = row < MP ? (row >> 12) : (NBP + ((row - MP) >> 2)); bb = bb < NBB ? bb : NBB - 1;
                const float* gp = modl + (size_t)(bb * 6 + jg) * D + col0; float* xp = X + (size_t)row * D + col0;
#pragma unroll
                for (int bj = 0; bj < 2; ++bj)
#pragma unroll
                    for (int n = 0; n < 2; ++n) { const f32x4 gv = *(const f32x4*)(gp + bj * HALF + n * 16); const f32x4 xv = *(const f32x4*)(xp + bj * HALF + n * 16);
                        *(f32x4*)(xp + bj * HALF + n * 16) = xv + gv * acc[ai][bj][m][n]; }
                asm volatile("" ::: "memory"); }
    }
};
struct EpiSwi {
    static constexpr bool PERM = true;
    bf16_t* H;
    __device__ __forceinline__ void operator()(const f32x4 (&acc)[2][2][4][2], const Unit& u, int wr, int wc, int fr, int fq) const {
        const int row0 = u.pm * BM + wr * 64 + fr, c0 = u.pn * HALF + wc * 32 + 8 * fq;
#pragma unroll
        for (int ai = 0; ai < 2; ++ai)
#pragma unroll
            for (int m = 0; m < 4; ++m) { bf16_t* rowp = H + (size_t)(row0 + ai * HALF + m * 16) * DFF + c0;
                f32x4 v0, v1;
#pragma unroll
                for (int j = 0; j < 4; ++j) { const float a0 = acc[ai][0][m][0][j], a1 = acc[ai][0][m][1][j]; v0[j] = a0 * sigmoidf_(a0) * acc[ai][1][m][0][j]; v1[j] = a1 * sigmoidf_(a1) * acc[ai][1][m][1][j]; }
                u32x4 w; w.x = cvt_pk_bf16(v0[0], v0[1]); w.y = cvt_pk_bf16(v0[2], v0[3]); w.z = cvt_pk_bf16(v1[0], v1[1]); w.w = cvt_pk_bf16(v1[2], v1[3]);
                *(u32x4*)rowp = w; }
    }
};
}

enum { I_XP = 0, I_XS, I_CP, I_CS, I_CB1, I_CB2, I_CB3, I_CPOOL, I_CCONV, I_LN1G, I_LN2G, I_WADA, I_BADA, I_WIN, I_WGATE, I_BGATE, I_ALNG, I_ALNB, I_AWS, I_ABS, I_RELB, I_POOLW, I_POOLB, I_POOLS, I_CONVW, I_WBR, I_WOUT, I_W1, I_W3, I_W2, I_FING };
__device__ __forceinline__ const float* inp(int i) {
    const __attribute__((address_space(4))) char* kp = (const __attribute__((address_space(4))) char*)__builtin_amdgcn_kernarg_segment_ptr();
    return *(const float* const volatile __attribute__((address_space(4)))*)(kp + 8 * i);
}
struct Frame {
    LAS unsigned char* lds;
    int tid, lane, wave, vcu, G;
    float* out; unsigned char* ws;
    __device__ __forceinline__ float* MOD() const { return (float*)(ws + WS_MOD); }
    __device__ __forceinline__ float* MODP() const { return (float*)(ws + WS_MODP); }
    __device__ __forceinline__ float* X() const { return (float*)(ws + WS_X); }
    __device__ __forceinline__ float* LSE() const { return (float*)(ws + WS_LSE); }
    __device__ __forceinline__ float* ACC() const { return (float*)(ws + WS_ACC); }
    __device__ __forceinline__ bf16_t* POOLWT() const { return (bf16_t*)(ws + WS_POOLWT); }
    __device__ __forceinline__ bf16_t* HN() const { return (bf16_t*)(ws + WS_HN); }
    __device__ __forceinline__ bf16_t* P() const { return (bf16_t*)(ws + WS_P); }
    __device__ __forceinline__ bf16_t* GATES() const { return (bf16_t*)(ws + WS_GATES); }
    __device__ __forceinline__ bf16_t* YS() const { return (bf16_t*)(ws + WS_YS); }
    __device__ __forceinline__ bf16_t* OG() const { return (bf16_t*)(ws + WS_OG); }
    __device__ __forceinline__ bf16_t* MERGED() const { return (bf16_t*)(ws + WS_MERGED); }
    __device__ __forceinline__ bf16_t* H() const { return (bf16_t*)(ws + WS_H); }
};

#define OPAQUE_IDS(F) int lane = (F).lane, wave = (F).wave; asm volatile("" : "+v"(lane)); asm volatile("" : "+s"(wave)); const int tid = wave * 64 + lane; (void)tid
__device__ __forceinline__ unsigned f2bf(float f) { unsigned u = __float_as_uint(f); return (u + 0x7fffu + ((u >> 16) & 1u)) >> 16; }
__device__ __forceinline__ unsigned pk2(float lo, float hi) { return f2bf(lo) | (f2bf(hi) << 16); }
__device__ __forceinline__ void transpose_item(const float* W, int N, int k0, int n0, bf16_t* WT, int ldk, int drow0, LAS float* scr, int lane) {
#pragma unroll 8
    for (int i = 0; i < 32; ++i) { const int kk = 2 * i + (lane >> 5); scr[kk * 33 + (lane & 31)] = W[(size_t)(k0 + kk) * N + n0 + (lane & 31)]; }
    asm volatile("s_waitcnt lgkmcnt(0)" ::: "memory");
    const int c = lane & 7;
#pragma unroll
    for (int j = 0; j < 4; ++j) { const int n = (lane >> 3) + 8 * j; const LAS float* s = scr + (8 * c) * 33 + n;
        u32x4 o; o.x = pk2(s[0 * 33], s[1 * 33]); o.y = pk2(s[2 * 33], s[3 * 33]); o.z = pk2(s[4 * 33], s[5 * 33]); o.w = pk2(s[6 * 33], s[7 * 33]);
        *(u32x4*)(WT + (size_t)(drow0 + n) * ldk + k0 + 8 * c) = o; }
    asm volatile("s_waitcnt lgkmcnt(0)" ::: "memory");
}
__device__ __forceinline__ void p0a_phase(const Frame& F) {
    OPAQUE_IDS(F);
    {
        LAS float* sl = (LAS float*)F.lds;
        LAS float* red = (LAS float*)(F.lds + 8192);
        const float* cpr = inp(I_CP); const float* csm = inp(I_CS); const float* wada = inp(I_WADA);
        for (int u = F.vcu; u < 768; u += F.G) {
            const int l = u / 192, rem = u % 192, cb = rem >> 4, ks = rem & 15;
            __syncthreads();
            for (int i = tid; i < 1280; i += NTHREADS) { const int bb = i >> 7, kk = i & 127;
                const float c = bb < NBP ? cpr[bb * D + ks * 128 + kk] : csm[(bb - NBP) * D + ks * 128 + kk];
                sl[i] = c / (1.0f + __expf(-c)); }
            __syncthreads();
            const int ct = tid & 255, kh = tid >> 8;
            const float* wp = wada + ((size_t)(l * D + ks * 128 + kh * 64)) * (6 * D) + cb * 1024 + ct * 4;
            f32x4 acc[NBB];
#pragma unroll
            for (int b = 0; b < NBB; ++b) acc[b] = (f32x4){0.f, 0.f, 0.f, 0.f};
#pragma unroll 8
            for (int kk = 0; kk < 64; ++kk) { const f32x4 w = *(const f32x4*)(wp + (size_t)kk * (6 * D));
#pragma unroll
                for (int b = 0; b < NBB; ++b) acc[b] += sl[b * 128 + kh * 64 + kk] * w; }
            if (kh == 1) {
#pragma unroll
                for (int b = 0; b < NBB; ++b) *(LAS f32x4*)(red + (ct * NBB + b) * 4) = acc[b]; }
            __syncthreads();
            if (kh == 0) {
#pragma unroll
                for (int b = 0; b < NBB; ++b) { const f32x4 o = acc[b] + *(const LAS f32x4*)(red + (ct * NBB + b) * 4);
                    *(f32x4*)(F.MODP() + ((size_t)((ks * DEPTH + l) * NBB + b)) * (6 * D) + cb * 1024 + ct * 4) = o; } }
        }
        __syncthreads();
    }
    {
        LAS float* scr = (LAS float*)(F.lds + wave * 16384);
        const int gw = F.vcu * NWAVES + wave, NGW = F.G * NWAVES;
        constexpr int C_IN = 32 * (NIN / 32), C_GATE = 32 * (NGATE / 32), C_BR = 8 * (D / 32), C_OUT = 32 * (D / 32), C_W1 = 32 * (DFF / 32), C_W2 = (DFF / 64) * (D / 32), C_PW = 2 * 4;
        constexpr int C_LAYER = C_IN + C_GATE + 4 * C_BR + C_OUT + 2 * C_W1 + C_W2 + 4 * C_PW;
        for (int it = gw; it < DEPTH * C_LAYER; it += NGW) {
            const int l = it / C_LAYER; int r = it % C_LAYER;
            if (r < C_IN) { const int nblk = NIN / 32, kb = r / nblk, nb = r % nblk; transpose_item(inp(I_WIN) + (size_t)l * D * NIN, NIN, 64 * kb, 32 * nb, (bf16_t*)(F.ws + WS_BT1 + l * BT1_L), D, 32 * nb, scr, lane); continue; } r -= C_IN;
            if (r < C_GATE) { const int nblk = NGATE / 32, kb = r / nblk, nb = r % nblk; transpose_item(inp(I_WGATE) + (size_t)l * D * NGATE, NGATE, 64 * kb, 32 * nb, (bf16_t*)(F.ws + WS_BT1 + l * BT1_L), D, NIN + 32 * nb, scr, lane); continue; } r -= C_GATE;
            if (r < 4 * C_BR) { const int g = r / C_BR, rr = r % C_BR, nblk = D / 32, kb = rr / nblk, nb = rr % nblk;
                transpose_item(inp(I_WBR) + ((size_t)(l * 4 + g)) * BRW * D, D, 64 * kb, 32 * nb, (bf16_t*)(F.ws + WS_BT2 + l * BT2_L) + (size_t)g * D * BRW, BRW, 32 * nb, scr, lane); continue; } r -= 4 * C_BR;
            if (r < C_OUT) { const int nblk = D / 32, kb = r / nblk, nb = r % nblk; transpose_item(inp(I_WOUT) + (size_t)l * D * D, D, 64 * kb, 32 * nb, (bf16_t*)(F.ws + WS_BT3 + l * BT3_L), D, 32 * nb, scr, lane); continue; } r -= C_OUT;
            if (r < 2 * C_W1) { const int which = r / C_W1, rr = r % C_W1, nblk = DFF / 32, kb = rr / nblk, nb = rr % nblk, n0 = 32 * nb;
                transpose_item((which ? inp(I_W3) : inp(I_W1)) + (size_t)l * D * DFF, DFF, 64 * kb, n0, (bf16_t*)(F.ws + WS_BT4 + l * BT4_L), D, (n0 >> 7) * 256 + which * 128 + (n0 & 127), scr, lane); continue; } r -= 2 * C_W1;
            if (r < C_W2) { const int nblk = D / 32, kb = r / nblk, nb = r % nblk; transpose_item(inp(I_W2) + (size_t)l * DFF * D, D, 64 * kb, 32 * nb, (bf16_t*)(F.ws + WS_BT5 + l * BT5_L), DFF, 32 * nb, scr, lane); continue; } r -= C_W2;
            { const int g = r / C_PW, rr = r % C_PW, kb = rr / 4, nb = rr % 4;
                transpose_item(inp(I_POOLW) + ((size_t)(l * 4 + g)) * 128 * 128, 128, 64 * kb, 32 * nb, F.POOLWT() + ((size_t)(l * 4 + g)) * 128 * 128, 128, 32 * nb, scr, lane); }
        }
        const float* xpr = inp(I_XP); const float* xsm = inp(I_XS);
        for (int row = gw; row < MREAL; row += NGW) {
            const f32x4* src = (const f32x4*)(row < MP ? xpr + (size_t)row * D : xsm + (size_t)(row - MP) * D) + lane; f32x4* dst = (f32x4*)(F.X() + (size_t)row * D) + lane;
#pragma unroll
            for (int j = 0; j < 8; ++j) dst[64 * j] = src[64 * j];
        }
    }
}
__device__ __forceinline__ void p0b_phase(const Frame& F) {
    const int n = DEPTH * NBB * 6 * D;
    const float* bada = inp(I_BADA); const float* l1g = inp(I_LN1G); const float* l2g = inp(I_LN2G);
    OPAQUE_IDS(F);
    for (int i = F.vcu * NTHREADS + tid; i < n; i += F.G * NTHREADS) {
        const int k = i & (D - 1), j = (i >> 11) % 6, bb = (i / (6 * D)) % NBB, l = i / (NBB * 6 * D), col = j * D + k;
        float s = bada[l * 6 * D + col];
#pragma unroll
        for (int ks = 0; ks < 16; ++ks) s += F.MODP()[((size_t)((ks * DEPTH + l) * NBB + bb)) * (6 * D) + col];
        if (j == 1) s = l1g[l * D + k] * (1.0f + s);
        if (j == 4) s = l2g[l * D + k] * (1.0f + s);
        F.MOD()[i] = s;
    }
}
__device__ __forceinline__ void norm_phase(const Frame& F, const float* modl, int jS, int jSH) {
    OPAQUE_IDS(F);
    const int gw = F.vcu * NWAVES + wave, NGW = F.G * NWAVES;
    for (int row = gw; row < MREAL; row += NGW) {
        const int bb = row < MP ? (row >> 12) : (NBP + ((row - MP) >> 2));
        const f32x4* xr = (const f32x4*)(F.X() + (size_t)row * D) + lane;
        f32x4 v[8]; float ss = 0.f;
#pragma unroll
        for (int j = 0; j < 8; ++j) { v[j] = xr[64 * j]; ss += (v[j].x * v[j].x + v[j].y * v[j].y) + (v[j].z * v[j].z + v[j].w * v[j].w); }
        const float rstd = 1.0f / sqrtf(wave_sum(ss) * (1.0f / D) + RMS_EPS);
        const f32x4* sp = (const f32x4*)(modl + (size_t)(bb * 6 + jS) * D) + lane; const f32x4* hp = (const f32x4*)(modl + (size_t)(bb * 6 + jSH) * D) + lane;
        u32x2* o = (u32x2*)(F.HN() + (size_t)row * D) + lane;
#pragma unroll
        for (int j = 0; j < 8; ++j) { const f32x4 s = sp[64 * j], h = hp[64 * j]; const f32x4 y = v[j] * rstd * s + h;
            u32x2 w; w.x = cvt_pk_bf16(y.x, y.y); w.y = cvt_pk_bf16(y.z, y.w); o[64 * j] = w; }
    }
}
__device__ __forceinline__ void final_norm_phase(const Frame& F) {
    OPAQUE_IDS(F);
    const int gw = F.vcu * NWAVES + wave, NGW = F.G * NWAVES;
    const float* fing = inp(I_FING);
    for (int row = gw; row < MREAL; row += NGW) {
        const f32x4* xr = (const f32x4*)(F.X() + (size_t)row * D) + lane;
        f32x4 v[8]; float ss = 0.f;
#pragma unroll
        for (int j = 0; j < 8; ++j) { v[j] = xr[64 * j]; ss += (v[j].x * v[j].x + v[j].y * v[j].y) + (v[j].z * v[j].z + v[j].w * v[j].w); }
        const float rstd = 1.0f / sqrtf(wave_sum(ss) * (1.0f / D) + RMS_EPS);
        const f32x4* gp = (const f32x4*)fing + lane; f32x4* o = (f32x4*)(F.out + OUT_Y + (size_t)row * D) + lane;
#pragma unroll
        for (int j = 0; j < 8; ++j) o[64 * j] = v[j] * rstd * gp[64 * j];
    }
}

constexpr int TP = 272;
constexpr int L_KBUF = 0, L_VRAW = 128 * TP, L_VT = 2 * 128 * TP, L_BT = 3 * 128 * TP;
template <bool PERMK> __device__ __forceinline__ void lds_transpose(LAS unsigned char* raw, LAS unsigned char* vt, int tid) {
#pragma unroll
    for (int i = 0; i < 4; ++i) { const int task = tid + NTHREADS * i, c = task & 127, sq = task >> 7, s = sq >> 2, q = sq & 3;
        unsigned short e[8];
#pragma unroll
        for (int jj = 0; jj < 8; ++jj) { const int row = PERMK ? (32 * s + 16 * (jj >> 2) + 4 * q + (jj & 3)) : (32 * s + 8 * q + jj); e[jj] = *(const LAS unsigned short*)(raw + row * TP + c * 2); }
        u32x4 w; w.x = e[0] | ((unsigned)e[1] << 16); w.y = e[2] | ((unsigned)e[3] << 16); w.z = e[4] | ((unsigned)e[5] << 16); w.w = e[6] | ((unsigned)e[7] << 16);
        *(LAS u32x4*)(vt + c * TP + (32 * s + 8 * q) * 2) = w; }
}
__device__ __forceinline__ void attn_prompt_unit(const Frame& F, int idx) {
    OPAQUE_IDS(F); const int fr = lane & 15, fq = lane >> 4;
    const int gi = idx >> 8, rem = idx & 255, h = rem & 3, blk = rem >> 2, b = blk >> 5, rb = blk & 31;
    const int dsh = 2 * gi, dm = (1 << dsh) - 1, r = rb & dm, n = rb >> dsh;
    const bf16_t* Pb = F.P() + (size_t)(b * SEQ) * NIN;
    const int qcol = 1024 + gi * 1536 + h * 128, kcol = qcol + 512, vcol = qcol + 1024;
    LAS unsigned char* kbuf = F.lds + L_KBUF; LAS unsigned char* vraw = F.lds + L_VRAW; LAS unsigned char* vt = F.lds + L_VT; LAS float* bt = (LAS float*)(F.lds + L_BT);
    __syncthreads();
    if (tid < 129) bt[tid] = inp(I_RELB)[(int)BKT[gi][tid] * 12 + gi * 4 + h];
    const int iq = 16 * wave + fr;
    const size_t qpos = ((size_t)(128 * n + iq) << dsh) + r;
    bf16x8 qf[4];
#pragma unroll
    for (int s = 0; s < 4; ++s) qf[s] = *(const bf16x8*)(Pb + qpos * NIN + qcol + 32 * s + 8 * fq);
    f32x4 S[16];
#pragma unroll
    for (int t = 0; t < 16; ++t) S[t] = (f32x4){0.f, 0.f, 0.f, 0.f};
    const int hf0 = (n == 0) ? 1 : 0;
#pragma unroll
    for (int hf = 0; hf < 2; ++hf) {
        if (hf >= hf0) {
#pragma unroll
            for (int i = 0; i < 4; ++i) { const int c = tid + NTHREADS * i, row = c >> 4, ch = c & 15; const size_t pk = ((size_t)(128 * (n - 1 + hf) + row) << dsh) + r;
                *(LAS u32x4*)(kbuf + row * TP + ch * 16) = *(const u32x4*)(Pb + pk * NIN + kcol + ch * 8); }
            __syncthreads();
#pragma unroll
            for (int t = 0; t < 8; ++t)
#pragma unroll
                for (int s = 0; s < 4; ++s) { const bf16x8 kf = *(const LAS bf16x8*)(kbuf + (16 * t + fr) * TP + 64 * s + 16 * fq);
                    S[hf * 8 + t] = __builtin_amdgcn_mfma_f32_16x16x32_bf16(kf, qf[s], S[hf * 8 + t], 0, 0, 0); if (s == 3 && (t & 1)) __builtin_amdgcn_sched_barrier(0); }
            __syncthreads();
        }
    }
    float mx = -3.0e38f;
#pragma unroll
    for (int T = 0; T < 16; ++T)
#pragma unroll
        for (int j = 0; j < 4; ++j) { const int jb = 16 * T + 4 * fq + j, diff = 128 + iq - jb; const bool valid = (diff >= 0) && (diff <= 128) && (jb >= 128 * hf0);
            const float lg = valid ? S[T][j] * ATT_SCALE + bt[valid ? diff : 0] : -1.0e30f; S[T][j] = lg; mx = fmaxf(mx, lg); if (j == 3) __builtin_amdgcn_sched_barrier(0); }
    mx = fmaxf(mx, __shfl_xor(mx, 16)); mx = fmaxf(mx, __shfl_xor(mx, 32));
    float sum = 0.f;
#pragma unroll
    for (int T = 0; T < 16; ++T)
#pragma unroll
        for (int j = 0; j < 4; ++j) { const float p = S[T][j] > -1.0e29f ? __expf(S[T][j] - mx) : 0.f; S[T][j] = p; sum += p; if (j == 3) __builtin_amdgcn_sched_barrier(0); }
    sum += __shfl_xor(sum, 16); sum += __shfl_xor(sum, 32);
    const float inv = 1.0f / sum, lse = mx + __logf(sum);
    bf16x8 pf[8];
#pragma unroll
    for (int ks = 0; ks < 8; ++ks) { const f32x4 a = S[2 * ks] * inv, c = S[2 * ks + 1] * inv;
        u32x4 w; w.x = cvt_pk_bf16(a[0], a[1]); w.y = cvt_pk_bf16(a[2], a[3]); w.z = cvt_pk_bf16(c[0], c[1]); w.w = cvt_pk_bf16(c[2], c[3]); pf[ks] = __builtin_bit_cast(bf16x8, w); }
    f32x4 O[8];
#pragma unroll
    for (int et = 0; et < 8; ++et) O[et] = (f32x4){0.f, 0.f, 0.f, 0.f};
#pragma unroll
    for (int hf = 0; hf < 2; ++hf) {
        if (hf >= hf0) {
#pragma unroll
            for (int i = 0; i < 4; ++i) { const int c = tid + NTHREADS * i, row = c >> 4, ch = c & 15; const size_t pk = ((size_t)(128 * (n - 1 + hf) + row) << dsh) + r;
                *(LAS u32x4*)(vraw + row * TP + ch * 16) = *(const u32x4*)(Pb + pk * NIN + vcol + ch * 8); }
            __syncthreads();
            lds_transpose<true>(vraw, vt, tid);
            __syncthreads();
#pragma unroll
            for (int s = 0; s < 4; ++s)
#pragma unroll
                for (int et = 0; et < 8; ++et) { const bf16x8 vf = *(const LAS bf16x8*)(vt + (16 * et + fr) * TP + 64 * s + 16 * fq);
                    O[et] = __builtin_amdgcn_mfma_f32_16x16x32_bf16(vf, pf[hf * 4 + s], O[et], 0, 0, 0); if (et == 7) __builtin_amdgcn_sched_barrier(0); }
        }
    }
    const size_t orow = (size_t)gi * MP + (size_t)b * SEQ + qpos;
    bf16_t* op = F.OG() + orow * BRW + h * 128 + 4 * fq;
#pragma unroll
    for (int et = 0; et < 8; ++et) { u32x2 w; w.x = cvt_pk_bf16(O[et][0], O[et][1]); w.y = cvt_pk_bf16(O[et][2], O[et][3]); *(u32x2*)(op + 16 * et) = w; }
    if (fq == 0) F.LSE()[orow * 4 + h] = lse;
}
__device__ __forceinline__ void gmlp_prompt_unit(const Frame& F, int l, int idx) {
    OPAQUE_IDS(F); const int fr = lane & 15, fq = lane >> 4;
    const int g = idx & 3, chunk = idx >> 2; const size_t row0 = (size_t)chunk * 128;
    LAS unsigned char* vraw = F.lds + L_VRAW; LAS unsigned char* vt = F.lds + L_VT;
    __syncthreads();
    {
        const int myg = lane >> 4, cl = (lane & 15) * 8; const float* alng = inp(I_ALNG); const float* alnb = inp(I_ALNB);
        float lg[8], lb[8];
#pragma unroll
        for (int i = 0; i < 8; ++i) { lg[i] = alng[l * BRW + myg * 128 + cl + i]; lb[i] = alnb[l * BRW + myg * 128 + cl + i]; }
#pragma unroll 4
        for (int rr = 0; rr < 16; ++rr) { const int j = 16 * wave + rr;
            const u32x4 raw = *(const u32x4*)(F.P() + (row0 + j) * NIN + 512 + lane * 8);
            float x[8]; unpack8(raw, x);
            float s = 0.f;
#pragma unroll
            for (int i = 0; i < 8; ++i) s += x[i];
            const float mean = wave_sum(s) * (1.0f / BRW); float q = 0.f;
#pragma unroll
            for (int i = 0; i < 8; ++i) { x[i] -= mean; q += x[i] * x[i]; }
            const float rstd = 1.0f / sqrtf(wave_sum(q) * (1.0f / BRW) + LN_EPS);
            if (myg == g) { float y[8];
#pragma unroll
                for (int i = 0; i < 8; ++i) y[i] = x[i] * rstd * lg[i] + lb[i];
                *(LAS u32x4*)(vraw + j * TP + (lane & 15) * 16) = pack8(y); }
        }
    }
    __syncthreads();
    lds_transpose<false>(vraw, vt, tid);
    __syncthreads();
    const int i_row = 16 * wave + fr; const float* aws = inp(I_AWS);
    f32x4 acc[8];
#pragma unroll
    for (int ct = 0; ct < 8; ++ct) acc[ct] = (f32x4){0.f, 0.f, 0.f, 0.f};
#pragma unroll
    for (int s = 0; s < 4; ++s) {
        if (32 * s <= 16 * wave + 15) {
            const float* wsp = aws + ((size_t)((l * 4 + g) * 128 + i_row)) * 128 + 32 * s + 8 * fq;
            const f32x4 w0 = *(const f32x4*)wsp, w1 = *(const f32x4*)(wsp + 4);
            float wv[8] = {w0[0], w0[1], w0[2], w0[3], w1[0], w1[1], w1[2], w1[3]};
#pragma unroll
            for (int jj = 0; jj < 8; ++jj) wv[jj] = (32 * s + 8 * fq + jj <= i_row) ? wv[jj] : 0.f;
            const bf16x8 wf = __builtin_bit_cast(bf16x8, pack8(wv));
#pragma unroll
            for (int ct = 0; ct < 8; ++ct) { const bf16x8 vf = *(const LAS bf16x8*)(vt + (16 * ct + fr) * TP + 64 * s + 16 * fq);
                acc[ct] = __builtin_amdgcn_mfma_f32_16x16x32_bf16(vf, wf, acc[ct], 0, 0, 0); }
        }
    }
    const float bsv = inp(I_ABS)[(l * 4 + g) * 128 + i_row];
#pragma unroll
    for (int ct = 0; ct < 8; ++ct) { const int c0 = g * 128 + 16 * ct + 4 * fq;
        const u32x2 uw = *(const u32x2*)(F.P() + (row0 + i_row) * NIN + c0);
        const float y0 = bflo(uw.x) * (acc[ct][0] + bsv), y1 = bfhi(uw.x) * (acc[ct][1] + bsv), y2 = bflo(uw.y) * (acc[ct][2] + bsv), y3 = bfhi(uw.y) * (acc[ct][3] + bsv);
        u32x2 w; w.x = cvt_pk_bf16(y0, y1); w.y = cvt_pk_bf16(y2, y3); *(u32x2*)(F.YS() + (row0 + i_row) * D + c0) = w; }
}
__device__ __forceinline__ void pool_prompt_unit(const Frame& F, int l, int idx) {
    OPAQUE_IDS(F); const int fr = lane & 15, fq = lane >> 4;
    const int gi = idx & 3, tile = idx >> 2, win = 2 << gi;
    const int t = ((tile & 31) << 7) + 16 * wave + fr;
    const size_t row = (size_t)tile * 128 + 16 * wave + fr;
    const float icnt = 1.0f / (float)((t + 1) < win ? (t + 1) : win);
    f32x4 acc[8];
#pragma unroll
    for (int dt = 0; dt < 8; ++dt) acc[dt] = (f32x4){0.f, 0.f, 0.f, 0.f};
    const bf16_t* pw = F.POOLWT() + ((size_t)(l * 4 + gi)) * 128 * 128; const float* poolb = inp(I_POOLB); const float* pools = inp(I_POOLS);
#pragma unroll
    for (int s = 0; s < 4; ++s) {
        const bf16_t* pc = F.P() + row * NIN + 5632 + gi * 128 + 32 * s + 8 * fq;
        float sum[8], cur[8];
        unpack8(*(const u32x4*)pc, cur);
#pragma unroll
        for (int i = 0; i < 8; ++i) sum[i] = cur[i];
        for (int k = 1; k < win; ++k) { if (t - k >= 0) { float v[8]; unpack8(*(const u32x4*)(pc - (size_t)k * NIN), v);
#pragma unroll
                for (int i = 0; i < 8; ++i) sum[i] += v[i]; } }
        float pl[8];
#pragma unroll
        for (int i = 0; i < 8; ++i) pl[i] = sum[i] * icnt - cur[i];
        const bf16x8 bfrag = __builtin_bit_cast(bf16x8, pack8(pl));
#pragma unroll
        for (int dt = 0; dt < 8; ++dt) { const bf16x8 af = *(const bf16x8*)(pw + (size_t)(16 * dt + fr) * 128 + 32 * s + 8 * fq);
            acc[dt] = __builtin_amdgcn_mfma_f32_16x16x32_bf16(af, bfrag, acc[dt], 0, 0, 0); }
        __builtin_amdgcn_sched_barrier(0);
    }
#pragma unroll
    for (int dt = 0; dt < 8; ++dt) { const int ch = gi * 128 + 16 * dt + 4 * fq;
        const f32x4 pb = *(const f32x4*)(poolb + l * BRW + ch), ps = *(const f32x4*)(pools + l * BRW + ch);
        const f32x4 y = (acc[dt] + pb) * ps;
        u32x2 w; w.x = cvt_pk_bf16(y[0], y[1]); w.y = cvt_pk_bf16(y[2], y[3]); *(u32x2*)(F.YS() + row * D + 1024 + ch) = w; }
}
__device__ __forceinline__ void conv_prompt_unit(const Frame& F, int l, int idx) {
    OPAQUE_IDS(F);
    const int b = idx >> 5, t0 = ((idx & 31) << 7) + 16 * wave;
    const size_t rowb = (size_t)b * SEQ;
    float w0[8], w1[8], w2[8];
    { const float* cw = inp(I_CONVW) + ((size_t)l * BRW + 8 * lane) * 3; float t[24];
#pragma unroll
        for (int i = 0; i < 6; ++i) { const f32x4 v = *(const f32x4*)(cw + 4 * i); t[4 * i] = v[0]; t[4 * i + 1] = v[1]; t[4 * i + 2] = v[2]; t[4 * i + 3] = v[3]; }
#pragma unroll
        for (int i = 0; i < 8; ++i) { w0[i] = t[3 * i]; w1[i] = t[3 * i + 1]; w2[i] = t[3 * i + 2]; } }
    float z2[8], z1[8];
#pragma unroll
    for (int i = 0; i < 8; ++i) { z2[i] = 0.f; z1[i] = 0.f; }
    for (int tt = t0 - 2; tt < t0 + 16; ++tt) {
        if (tt < 0) continue;
        const bf16_t* pr = F.P() + (rowb + tt) * NIN + 6144 + 8 * lane;
        float cg[8], hs[8], z[8]; unpack8(*(const u32x4*)(pr + 512), cg); unpack8(*(const u32x4*)(pr + 1024), hs);
#pragma unroll
        for (int i = 0; i < 8; ++i) z[i] = cg[i] * hs[i];
        if (tt >= t0) {
            float bg[8], y[8]; unpack8(*(const u32x4*)pr, bg);
#pragma unroll
            for (int i = 0; i < 8; ++i) y[i] = bg[i] * (z2[i] * w0[i] + z1[i] * w1[i] + z[i] * w2[i]);
            *(u32x4*)(F.YS() + (rowb + tt) * D + 1536 + 8 * lane) = pack8(y);
            if (tt >= SEQ - 2) { float* o = F.out + OUT_CONVP + ((size_t)((l * NBP + b) * 2 + (tt - (SEQ - 2)))) * BRW + 8 * lane;
                *(f32x4*)o = (f32x4){z[0], z[1], z[2], z[3]}; *(f32x4*)(o + 4) = (f32x4){z[4], z[5], z[6], z[7]}; }
        }
#pragma unroll
        for (int i = 0; i < 8; ++i) { z2[i] = z1[i]; z1[i] = z[i]; }
    }
}
__device__ __forceinline__ void attn_sample_unit(const Frame& F, int l, int idx) {
    OPAQUE_IDS(F);
    const int h = idx & 3, t = (idx >> 2) & 3, b = idx >> 4;
    LAS float* qs = (LAS float*)F.lds;
    LAS float* ps = qs + 384;
    LAS float* os = ps + 396;
    LAS float* ls = os + 384;
    const size_t prow = (size_t)(MP + b * TS + t);
    __syncthreads();
    if (wave < 3) {
        const int gi = wave, dsh = 2 * gi, wb = 128 << dsh;
        const int qcol = 1024 + gi * 1536 + h * 128, kcol = qcol + 512, vcol = qcol + 1024;
        { const unsigned qw = *(const unsigned*)(F.P() + prow * NIN + qcol + 2 * lane); qs[gi * 128 + 2 * lane] = bflo(qw); qs[gi * 128 + 2 * lane + 1] = bfhi(qw); }
        { float* ob = F.out + (gi == 0 ? OUT_B1S : (gi == 1 ? OUT_B2S : OUT_B3S)) + ((size_t)((l * NBS + b) * TS + t)) * 1024 + h * 128 + 2 * lane;
            const unsigned kw = *(const unsigned*)(F.P() + prow * NIN + kcol + 2 * lane), vw = *(const unsigned*)(F.P() + prow * NIN + vcol + 2 * lane);
            *(f32x2*)ob = (f32x2){bflo(kw), bfhi(kw)}; *(f32x2*)(ob + 512) = (f32x2){bflo(vw), bfhi(vw)}; }
        asm volatile("s_waitcnt lgkmcnt(0)" ::: "memory");
        const float* relb = inp(I_RELB);
        const float* cache = inp(I_CB1 + gi) + ((size_t)(l * NBS + b) * wb) * 1024;
        float lg[3]; float mx = -3.0e38f;
#pragma unroll
        for (int k3 = 0; k3 < 3; ++k3) { const int st = lane + 64 * k3; lg[k3] = -3.0e38f;
            if (st <= 128) { const int kidx = wb + t - (st << dsh); float dot = 0.f;
                if (kidx < wb) { const float* kp = cache + (size_t)kidx * 1024 + h * 128;
#pragma unroll 8
                    for (int e = 0; e < 128; e += 4) { const f32x4 kv = *(const f32x4*)(kp + e); const f32x4 qv = *(const LAS f32x4*)(qs + gi * 128 + e); dot += (kv[0] * qv[0] + kv[1] * qv[1]) + (kv[2] * qv[2] + kv[3] * qv[3]); } }
                else { const bf16_t* kp = F.P() + (size_t)(MP + b * TS + (kidx - wb)) * NIN + kcol;
#pragma unroll 4
                    for (int e = 0; e < 128; e += 8) { float kv[8]; unpack8(*(const u32x4*)(kp + e), kv);
#pragma unroll
                        for (int i = 0; i < 8; ++i) dot += kv[i] * qs[gi * 128 + e + i]; } }
                lg[k3] = dot * ATT_SCALE + relb[(int)BKT[gi][st] * 12 + gi * 4 + h]; mx = fmaxf(mx, lg[k3]); } }
        mx = wave_max(mx);
        float sum = 0.f;
#pragma unroll
        for (int k3 = 0; k3 < 3; ++k3) { const int st = lane + 64 * k3; if (st <= 128) { lg[k3] = __expf(lg[k3] - mx); sum += lg[k3]; } }
        sum = wave_sum(sum);
        const float inv = 1.0f / sum;
#pragma unroll
        for (int k3 = 0; k3 < 3; ++k3) { const int st = lane + 64 * k3; if (st <= 128) ps[gi * 132 + st] = lg[k3] * inv; }
        asm volatile("s_waitcnt lgkmcnt(0)" ::: "memory");
        float o0 = 0.f, o1 = 0.f;
        for (int st = 0; st <= 128; ++st) { const int kidx = wb + t - (st << dsh); const float p = ps[gi * 132 + st];
            if (kidx < wb) { const f32x2 v = *(const f32x2*)(cache + (size_t)kidx * 1024 + 512 + h * 128 + 2 * lane); o0 += p * v[0]; o1 += p * v[1]; }
            else { const unsigned vw = *(const unsigned*)(F.P() + (size_t)(MP + b * TS + (kidx - wb)) * NIN + vcol + 2 * lane); o0 += p * bflo(vw); o1 += p * bfhi(vw); } }
        os[gi * 128 + 2 * lane] = o0; os[gi * 128 + 2 * lane + 1] = o1;
        if (lane == 0) ls[gi] = mx + __logf(sum);
    }
    __syncthreads();
    if (tid < 128) { const float l0 = ls[0], l1 = ls[1], l2 = ls[2], m = fmaxf(l0, fmaxf(l1, l2)); const float e0 = __expf(l0 - m), e1 = __expf(l1 - m), e2 = __expf(l2 - m), inv = 1.0f / (e0 + e1 + e2);
        const float y = (e0 * os[tid] + e1 * os[128 + tid] + e2 * os[256 + tid]) * inv;
        F.YS()[prow * D + 512 + h * 128 + tid] = (bf16_t)f2bf(y); }
}
__device__ __forceinline__ void misc_sample_unit(const Frame& F, int l, int b) {
    OPAQUE_IDS(F);
    LAS float* red = (LAS float*)F.lds;
    LAS float* pl = red + 64;
    const size_t prow = (size_t)(MP + b * TS);
    __syncthreads();
    float vx[4], s4[4];
#pragma unroll
    for (int j = 0; j < 4; ++j) { vx[j] = bf1(F.P()[(prow + j) * NIN + 512 + tid]); s4[j] = wave_sum(vx[j]); }
    if (lane == 0) {
#pragma unroll
        for (int j = 0; j < 4; ++j) red[wave * 4 + j] = s4[j]; }
    __syncthreads();
    float mean[4];
#pragma unroll
    for (int j = 0; j < 4; ++j) { float s = 0.f;
#pragma unroll
        for (int w = 0; w < 8; ++w) s += red[w * 4 + j];
        mean[j] = s * (1.0f / BRW); vx[j] -= mean[j]; }
    __syncthreads();
#pragma unroll
    for (int j = 0; j < 4; ++j) s4[j] = wave_sum(vx[j] * vx[j]);
    if (lane == 0) {
#pragma unroll
        for (int j = 0; j < 4; ++j) red[wave * 4 + j] = s4[j]; }
    __syncthreads();
    const float lng = inp(I_ALNG)[l * BRW + tid], lnb = inp(I_ALNB)[l * BRW + tid];
    float v[4];
#pragma unroll
    for (int j = 0; j < 4; ++j) { float s = 0.f;
#pragma unroll
        for (int w = 0; w < 8; ++w) s += red[w * 4 + j];
        v[j] = vx[j] / sqrtf(s * (1.0f / BRW) + LN_EPS) * lng + lnb;
        F.out[OUT_CHUNKV + ((size_t)((l * NBS + b) * TS + j)) * BRW + tid] = v[j]; }
    { const int g = tid >> 7; const float* wsb = inp(I_AWS) + ((size_t)(l * 4 + g)) * 128 * 128; const float* absp = inp(I_ABS);
#pragma unroll
        for (int i = 0; i < 4; ++i) { float mix = absp[(l * 4 + g) * 128 + i];
#pragma unroll
            for (int j = 0; j < 4; ++j) if (j <= i) mix += wsb[i * 128 + j] * v[j];
            const float u = bf1(F.P()[(prow + i) * NIN + tid]);
            F.YS()[(prow + i) * D + tid] = (bf16_t)f2bf(u * mix); } }
    { const int gi = tid >> 7, win = 2 << gi; float full[19]; const float* cpool = inp(I_CPOOL);
#pragma unroll
        for (int k = 0; k < 15; ++k) full[k] = cpool[((size_t)((l * NBS + b) * 15 + k)) * BRW + tid];
#pragma unroll
        for (int j = 0; j < 4; ++j) { full[15 + j] = bf1(F.P()[(prow + j) * NIN + 5632 + tid]); F.out[OUT_POOLS + ((size_t)((l * NBS + b) * TS + j)) * BRW + tid] = full[15 + j]; }
#pragma unroll
        for (int j = 0; j < 4; ++j) { float s = 0.f;
#pragma unroll
            for (int k = 0; k < 16; ++k) if (k < win) s += full[15 + j - k];
            pl[j * BRW + tid] = s / (float)win - full[15 + j]; } }
    __syncthreads();
    { const int g = tid >> 7, d = tid & 127; const float* pw = inp(I_POOLW) + ((size_t)(l * 4 + g)) * 128 * 128 + d;
        float y[4] = {0.f, 0.f, 0.f, 0.f};
#pragma unroll 8
        for (int c = 0; c < 128; ++c) { const float w = pw[c * 128];
#pragma unroll
            for (int j = 0; j < 4; ++j) y[j] += pl[j * BRW + g * 128 + c] * w; }
        const float pb = inp(I_POOLB)[l * BRW + tid], psc = inp(I_POOLS)[l * BRW + tid];
#pragma unroll
        for (int j = 0; j < 4; ++j) F.YS()[(prow + j) * D + 1024 + tid] = (bf16_t)f2bf((y[j] + pb) * psc); }
    { const float* cvw = inp(I_CONVW) + ((size_t)l * BRW + tid) * 3; const float* ccv = inp(I_CCONV) + ((size_t)(l * NBS + b) * 2) * BRW + tid; const float w0 = cvw[0], w1 = cvw[1], w2 = cvw[2];
        float z2 = ccv[0], z1 = ccv[BRW];
#pragma unroll
        for (int j = 0; j < 4; ++j) { const bf16_t* pr = F.P() + (prow + j) * NIN + 6144 + tid; const float z = bf1(pr[512]) * bf1(pr[1024]);
            const float y = bf1(pr[0]) * (z2 * w0 + z1 * w1 + z * w2);
            F.YS()[(prow + j) * D + 1536 + tid] = (bf16_t)f2bf(y); F.out[OUT_CONVS + ((size_t)((l * NBS + b) * TS + j)) * BRW + tid] = z; z2 = z1; z1 = z; } }
}
constexpr int MX_SATT = 0, MX_SMISC = 128, MX_ATT = 136, MX_GMLP = 904, MX_POOL = 1160, MX_CONV = 1416, MX_END = 1480;
#ifndef UNIT_MASK
#define UNIT_MASK 0xFF
#endif
#define UON(k) (((UNIT_MASK) >> (k)) & 1)
__device__ __forceinline__ void mixer_phase(const Frame& F, int l) {
    for (int u = F.vcu; u < MX_END; u += F.G) {
        if (u < MX_SMISC) { if (UON(0)) attn_sample_unit(F, l, u); }
        else if (u < MX_ATT) { if (UON(1)) misc_sample_unit(F, l, u - MX_SMISC); }
        else if (u < MX_GMLP) { if (UON(2)) attn_prompt_unit(F, u - MX_ATT); }
        else if (u < MX_POOL) { if (UON(3)) gmlp_prompt_unit(F, l, u - MX_GMLP); }
        else if (u < MX_CONV) { if (UON(4)) pool_prompt_unit(F, l, u - MX_POOL); }
        else { if (UON(5)) conv_prompt_unit(F, l, u - MX_CONV); }
    }
}
__device__ __forceinline__ void combine_phase(const Frame& F, int l) {
    OPAQUE_IDS(F);
    const int gw = F.vcu * NWAVES + wave, NGW = F.G * NWAVES;
    for (int row = gw; row < MP; row += NGW) {
        const int h = lane >> 4;
        const float l0 = F.LSE()[((size_t)0 * MP + row) * 4 + h], l1 = F.LSE()[((size_t)1 * MP + row) * 4 + h], l2 = F.LSE()[((size_t)2 * MP + row) * 4 + h];
        const float m = fmaxf(l0, fmaxf(l1, l2)), e0 = __expf(l0 - m), e1 = __expf(l1 - m), e2 = __expf(l2 - m), inv = 1.0f / (e0 + e1 + e2);
        float a[8], c[8], y[8];
        unpack8(*(const u32x4*)(F.OG() + ((size_t)0 * MP + row) * BRW + 8 * lane), a);
#pragma unroll
        for (int i = 0; i < 8; ++i) y[i] = e0 * a[i];
        unpack8(*(const u32x4*)(F.OG() + ((size_t)1 * MP + row) * BRW + 8 * lane), c);
#pragma unroll
        for (int i = 0; i < 8; ++i) y[i] += e1 * c[i];
        unpack8(*(const u32x4*)(F.OG() + ((size_t)2 * MP + row) * BRW + 8 * lane), a);
#pragma unroll
        for (int i = 0; i < 8; ++i) y[i] = (y[i] + e2 * a[i]) * inv;
        *(u32x4*)(F.YS() + (size_t)row * D + 512 + 8 * lane) = pack8(y);
    }
    constexpr int NR = NBP * (128 + 512 + 2048);
    for (int it = gw; it < NR; it += NGW) {
        int gi, rem;
        if (it < NBP * 128) { gi = 0; rem = it; } else if (it < NBP * (128 + 512)) { gi = 1; rem = it - NBP * 128; } else { gi = 2; rem = it - NBP * (128 + 512); }
        const int keep = 128 << (2 * gi), b = rem / keep, rr = rem % keep;
        const bf16_t* src = F.P() + ((size_t)b * SEQ + SEQ - keep + rr) * NIN + 1024 + gi * 1536 + 512 + 16 * lane;
        float* dst = F.out + (gi == 0 ? OUT_B1P : (gi == 1 ? OUT_B2P : OUT_B3P)) + ((size_t)((l * NBP + b) * keep + rr)) * 1024 + 16 * lane;
        float a[8], c[8]; unpack8(*(const u32x4*)src, a); unpack8(*(const u32x4*)(src + 8), c);
        *(f32x4*)dst = (f32x4){a[0], a[1], a[2], a[3]}; *(f32x4*)(dst + 4) = (f32x4){a[4], a[5], a[6], a[7]};
        *(f32x4*)(dst + 8) = (f32x4){c[0], c[1], c[2], c[3]}; *(f32x4*)(dst + 12) = (f32x4){c[4], c[5], c[6], c[7]};
    }
    for (int it = gw; it < NBP * 15; it += NGW) { const int b = it / 15, rr = it % 15;
        float a[8]; unpack8(*(const u32x4*)(F.P() + ((size_t)b * SEQ + SEQ - 15 + rr) * NIN + 5632 + 8 * lane), a);
        float* dst = F.out + OUT_POOLP + ((size_t)((l * NBP + b) * 15 + rr)) * BRW + 8 * lane;
        *(f32x4*)dst = (f32x4){a[0], a[1], a[2], a[3]}; *(f32x4*)(dst + 4) = (f32x4){a[4], a[5], a[6], a[7]}; }
}


__device__ __forceinline__ void skinny_res(const Frame& F, const bf16_t* A, const bf16_t* Bt, int ld, int K, const float* modl, int jg) {
    OPAQUE_IDS(F); const int fr = lane & 15, fq = lane >> 4;
    LAS f32x4* red = (LAS f32x4*)F.lds;
    const int kw = K / 8;
    for (int p = F.vcu; p < D / 16; p += F.G) {
        const int n0 = 16 * p;
        const bf16_t* ap = A + (size_t)(MP + fr) * ld + wave * kw + 8 * fq;
        const bf16_t* bp = Bt + (size_t)(n0 + fr) * ld + wave * kw + 8 * fq;
        f32x4 a0 = (f32x4){0.f, 0.f, 0.f, 0.f}, a1 = a0;
#pragma unroll 2
        for (int ks = 0; ks < kw / 32; ++ks) { const bf16x8 bf = *(const bf16x8*)(bp + 32 * ks), x0 = *(const bf16x8*)(ap + 32 * ks), x1 = *(const bf16x8*)(ap + (size_t)16 * ld + 32 * ks);
            a0 = __builtin_amdgcn_mfma_f32_16x16x32_bf16(bf, x0, a0, 0, 0, 0); a1 = __builtin_amdgcn_mfma_f32_16x16x32_bf16(bf, x1, a1, 0, 0, 0); }
        __syncthreads();
        red[(wave * 2 + 0) * 64 + lane] = a0; red[(wave * 2 + 1) * 64 + lane] = a1;
        __syncthreads();
        if (wave < 2) { f32x4 sm = red[wave * 64 + lane];
#pragma unroll
            for (int w = 1; w < 8; ++w) sm += red[(w * 2 + wave) * 64 + lane];
            const int row = MP + 16 * wave + fr, col = n0 + 4 * fq, bb = NBP + ((row - MP) >> 2);
            const f32x4 gv = *(const f32x4*)(modl + (size_t)(bb * 6 + jg) * D + col); f32x4* xp = (f32x4*)(F.X() + (size_t)row * D + col); *xp = *xp + gv * sm; }
    }
}
__device__ __forceinline__ void skinny_branch(const Frame& F, int l) {
    OPAQUE_IDS(F); const int fr = lane & 15, fq = lane >> 4;
    LAS f32x4* red = (LAS f32x4*)F.lds;
    const int g = wave >> 1, kh = wave & 1;
    const bf16_t* Bt2 = (const bf16_t*)(F.ws + WS_BT2 + l * BT2_L);
    for (int p = F.vcu; p < D / 16; p += F.G) {
        const int n0 = 16 * p;
        const bf16_t* ap = F.YS() + (size_t)(MP + fr) * D + g * BRW + kh * 256 + 8 * fq;
        const bf16_t* bp = Bt2 + ((size_t)g * D + n0 + fr) * BRW + kh * 256 + 8 * fq;
        f32x4 a0 = (f32x4){0.f, 0.f, 0.f, 0.f}, a1 = a0;
#pragma unroll 2
        for (int ks = 0; ks < 8; ++ks) { const bf16x8 bf = *(const bf16x8*)(bp + 32 * ks), x0 = *(const bf16x8*)(ap + 32 * ks), x1 = *(const bf16x8*)(ap + (size_t)16 * D + 32 * ks);
            a0 = __builtin_amdgcn_mfma_f32_16x16x32_bf16(bf, x0, a0, 0, 0, 0); a1 = __builtin_amdgcn_mfma_f32_16x16x32_bf16(bf, x1, a1, 0, 0, 0); }
        const bf16_t* gp = F.GATES() + (size_t)(MP + fr) * NGATE + (size_t)g * D + n0 + 4 * fq;
        const u32x2 g0 = *(const u32x2*)gp, g1 = *(const u32x2*)(gp + (size_t)16 * NGATE);
        a0 *= (f32x4){bflo(g0.x), bfhi(g0.x), bflo(g0.y), bfhi(g0.y)}; a1 *= (f32x4){bflo(g1.x), bfhi(g1.x), bflo(g1.y), bfhi(g1.y)};
        __syncthreads();
        red[(wave * 2 + 0) * 64 + lane] = a0; red[(wave * 2 + 1) * 64 + lane] = a1;
        __syncthreads();
        if (wave < 2) { f32x4 sm = red[wave * 64 + lane];
#pragma unroll
            for (int w = 1; w < 8; ++w) sm += red[(w * 2 + wave) * 64 + lane];
            u32x2 o; o.x = cvt_pk_bf16(sm[0], sm[1]); o.y = cvt_pk_bf16(sm[2], sm[3]);
            *(u32x2*)(F.MERGED() + (size_t)(MP + 16 * wave + fr) * D + n0 + 4 * fq) = o; }
    }
}

struct Args { const float* in[31]; float* out; unsigned char* ws; int ph_lo, ph_hi; };
constexpr int PH_PER_LAYER = 9, PH_FINAL = 2 + DEPTH * PH_PER_LAYER, N_PHASES = PH_FINAL + 1;

__global__ void __launch_bounds__(NTHREADS, 2) fwd_kernel(Args args) {
    extern __shared__ __attribute__((aligned(16))) unsigned char lds_raw[];
    Frame F;
    F.lds = (LAS unsigned char*)lds_raw;
    F.tid = threadIdx.x; F.lane = F.tid & 63; F.wave = __builtin_amdgcn_readfirstlane(F.tid >> 6);
    F.G = gridDim.x; { const int bx = blockIdx.x; F.vcu = (F.G % 8 == 0) ? (bx % 8) * (F.G / 8) + bx / 8 : bx; }
    F.out = args.out; F.ws = args.ws;
    unsigned char* ws = args.ws;

    volatile LAS unsigned* MISC = (volatile LAS unsigned*)(F.lds + MISC_OFF);
    for (int u = F.tid; u < (LDS_BYTES - LDSCTL_OFF) / 4; u += NTHREADS) ((LAS unsigned*)(F.lds + LDSCTL_OFF))[u] = 0u;
    __syncthreads();
    const int lo = args.ph_lo, hi = args.ph_hi;
    XcdBarrier bar; bar.bar = (unsigned*)(ws + WS_CTL) + CW_BAR; bar.x = 0; bar.st = nullptr;
    if (hi - lo > 1) bar = xcd_barrier_post((unsigned*)(ws + WS_CTL) + CW_BAR, MISC + 8);
#ifndef PHASE_MASK
#define PHASE_MASK 0xFFFF
#endif
#define ON(kind) (((PHASE_MASK) >> (kind)) & 1)
#ifndef PROBE_DUP
#define PROBE_DUP -1
#endif
#define DUP(kind) for (int rep_ = 0; rep_ < ((PROBE_DUP) == (kind) ? 2 : 1); ++rep_)
#define IN(k) (lo <= (k) && (k) < hi)
#define SEAM(k) do { if (IN(k) && IN((k) + 1)) xcd_barrier(bar); } while (0)

    if (ON(0) && IN(0)) DUP(0) { p0a_phase(F); } SEAM(0);
    if (ON(1) && IN(1)) { p0b_phase(F); } SEAM(1);
    for (int l = 0; l < DEPTH; ++l) {
        const int pb = 2 + l * PH_PER_LAYER;
        const float* modl = F.MOD() + (size_t)l * NBB * 6 * D;
        if (ON(2) && IN(pb + 0)) DUP(2) { norm_phase(F, modl, 1, 0); } SEAM(pb + 0);
        if (ON(3) && IN(pb + 1)) DUP(3) {
            pg8::Gemm g{F.HN(), (const bf16_t*)(ws + WS_BT1 + l * BT1_L), D, D, D}; pg8::StaticOrder S; S.init(MPAD / 256, N1 / 256, F.G, (int)blockIdx.x, D, D);
            pg8::Epi1 E{F.P(), F.GATES(), inp(I_BGATE) + (size_t)l * NGATE};
            pg8::gemm_phase<pg8::Epi1, pg8::StaticOrder>(F.lds, g, S, E);
        } SEAM(pb + 1);
        if (ON(4) && IN(pb + 2)) DUP(4) { mixer_phase(F, l); } SEAM(pb + 2);
        if (ON(5) && IN(pb + 3)) DUP(5) { combine_phase(F, l); } SEAM(pb + 3);
        if (ON(6) && IN(pb + 4)) DUP(6) {
            pg8::Gemm g{F.YS(), (const bf16_t*)(ws + WS_BT2 + l * BT2_L), D, BRW, BRW}; pg8::BranchOrder S{F.G, F.vcu, (MP / 256) * (D / 256)};
            pg8::Epi2 E{F.GATES(), F.MERGED(), F.ACC() + (size_t)F.vcu * (32 * 512 * 4)};
            pg8::gemm_phase<pg8::Epi2, pg8::BranchOrder>(F.lds, g, S, E);
            skinny_branch(F, l);
        } SEAM(pb + 4);
        if (ON(7) && IN(pb + 5)) DUP(7) {
            pg8::Gemm g{F.MERGED(), (const bf16_t*)(ws + WS_BT3 + l * BT3_L), D, D, D}; pg8::StaticOrder S; S.init(MP / 256, D / 256, F.G, (int)blockIdx.x, D, D);
            pg8::EpiRes E{rep_ ? (float*)(ws + WS_H) : F.X(), modl, 2};
            pg8::gemm_phase<pg8::EpiRes, pg8::StaticOrder>(F.lds, g, S, E);
            if (!rep_) skinny_res(F, F.MERGED(), (const bf16_t*)(ws + WS_BT3 + l * BT3_L), D, D, modl, 2);
        } SEAM(pb + 5);
        if (ON(8) && IN(pb + 6)) { norm_phase(F, modl, 4, 3); } SEAM(pb + 6);
        if (ON(9) && IN(pb + 7)) DUP(9) {
            pg8::Gemm g{F.HN(), (const bf16_t*)(ws + WS_BT4 + l * BT4_L), D, D, D}; pg8::StaticOrder S; S.init(MPAD / 256, N4 / 256, F.G, (int)blockIdx.x, D, D);
            pg8::EpiSwi E{F.H()};
            pg8::gemm_phase<pg8::EpiSwi, pg8::StaticOrder>(F.lds, g, S, E);
        } SEAM(pb + 7);
        if (ON(10) && IN(pb + 8)) DUP(10) {
            pg8::Gemm g{F.H(), (const bf16_t*)(ws + WS_BT5 + l * BT5_L), DFF, DFF, DFF}; pg8::StaticOrder S; S.init(MP / 256, D / 256, F.G, (int)blockIdx.x, DFF, DFF);
            pg8::EpiRes E{rep_ ? (float*)(ws + WS_P) : F.X(), modl, 5};
            pg8::gemm_phase<pg8::EpiRes, pg8::StaticOrder>(F.lds, g, S, E);
            if (!rep_) skinny_res(F, F.H(), (const bf16_t*)(ws + WS_BT5 + l * BT5_L), DFF, DFF, modl, 5);
        } SEAM(pb + 8);
    }
    if (ON(11) && IN(PH_FINAL)) { final_norm_phase(F); }
#undef IN
#undef SEAM
}

extern "C" void kernel_launch(void* const* d_in, const int* in_sizes, int n_in, void* d_out, int out_size, void* d_ws, size_t ws_size, hipStream_t stream) {
    static int grid = 0;
    if (grid == 0) {
        if (n_in != 31 || (size_t)out_size != OUT_END || ws_size < WS_END) { fprintf(stderr, "kernel_launch: unexpected problem (n_in %d, out %d, ws %zu)\n", n_in, out_size, ws_size); grid = -1; return; }
        int dev = 0, cus = 0, per_cu = 0;
        if (hipGetDevice(&dev) != hipSuccess || hipDeviceGetAttribute(&cus, hipDeviceAttributeMultiprocessorCount, dev) != hipSuccess) { grid = -1; return; }
        if (hipFuncSetAttribute((const void*)fwd_kernel, hipFuncAttributeMaxDynamicSharedMemorySize, LDS_BYTES) != hipSuccess) { fprintf(stderr, "kernel_launch: hipFuncSetAttribute failed\n"); grid = -1; return; }
        if (hipOccupancyMaxActiveBlocksPerMultiprocessor(&per_cu, (const void*)fwd_kernel, NTHREADS, LDS_BYTES) != hipSuccess || per_cu < 1) fprintf(stderr, "kernel_launch: occupancy query reports %d\n", per_cu);
        (void)hipGetLastError();
        grid = cus < 256 ? cus : 256;
    }
    if (grid < 0) return;
    if (hipMemsetAsync((char*)d_ws + WS_CTL, 0, CTL_ZERO_BYTES, stream) != hipSuccess) return;
    Args a{};
    for (int i = 0; i < 31; ++i) a.in[i] = (const float*)d_in[i];
    a.out = (float*)d_out; a.ws = (unsigned char*)d_ws;
#if MK_MULTI_LAUNCH
    for (int ph = 0; ph < N_PHASES; ++ph) { a.ph_lo = ph; a.ph_hi = ph + 1; hipLaunchKernelGGL(fwd_kernel, dim3(grid), dim3(NTHREADS), LDS_BYTES, stream, a); }
#else
    a.ph_lo = 0; a.ph_hi = N_PHASES; hipLaunchKernelGGL(fwd_kernel, dim3(grid), dim3(NTHREADS), LDS_BYTES, stream, a);
#endif
}
```

```cpp
#include <hip/hip_runtime.h>
#include <cstdio>
#include <cstdint>

#ifndef MK_MULTI_LAUNCH
#define MK_MULTI_LAUNCH 0
#endif

#define LAS __attribute__((address_space(3)))
#define GAS __attribute__((address_space(1)))
typedef unsigned short bf16_t;
typedef short bf16x8 __attribute__((ext_vector_type(8)));
typedef float f32x4 __attribute__((ext_vector_type(4)));
typedef float f32x2 __attribute__((ext_vector_type(2)));
typedef unsigned u32x4 __attribute__((ext_vector_type(4)));
typedef unsigned u32x2 __attribute__((ext_vector_type(2)));

constexpr int D = 2048, SEQ = 4096, NBP = 2, MP = NBP * SEQ, NBS = 8, TS = 4, MS = NBS * TS, MREAL = MP + MS, MPAD = 8448;
constexpr int NIN = 7680, NGATE = 8192, N1 = NIN + NGATE, DFF = 5632, N4 = 2 * DFF, BRW = 512, DEPTH = 4, NBB = NBP + NBS;
constexpr int NWAVES = 8, NTHREADS = 512;
constexpr float RMS_EPS = 1e-6f, LN_EPS = 1e-5f;
constexpr float ATT_SCALE = 0.08838834764831845f;

constexpr size_t OUT_Y = 0;
constexpr size_t OUT_B1P = (size_t)MREAL * D;
constexpr size_t OUT_B2P = OUT_B1P + (size_t)DEPTH * NBP * 128 * 1024;
constexpr size_t OUT_B3P = OUT_B2P + (size_t)DEPTH * NBP * 512 * 1024;
constexpr size_t OUT_POOLP = OUT_B3P + (size_t)DEPTH * NBP * 2048 * 1024;
constexpr size_t OUT_CONVP = OUT_POOLP + (size_t)DEPTH * NBP * 15 * 512;
constexpr size_t OUT_B1S = OUT_CONVP + (size_t)DEPTH * NBP * 2 * 512;
constexpr size_t OUT_B2S = OUT_B1S + (size_t)DEPTH * NBS * TS * 1024;
constexpr size_t OUT_B3S = OUT_B2S + (size_t)DEPTH * NBS * TS * 1024;
constexpr size_t OUT_POOLS = OUT_B3S + (size_t)DEPTH * NBS * TS * 1024;
constexpr size_t OUT_CONVS = OUT_POOLS + (size_t)DEPTH * NBS * TS * 512;
constexpr size_t OUT_CHUNKV = OUT_CONVS + (size_t)DEPTH * NBS * TS * 512;
constexpr size_t OUT_END = OUT_CHUNKV + (size_t)DEPTH * NBS * TS * 512;
static_assert(OUT_END == 39522304, "output size");

constexpr size_t MiB = 1u << 20;
constexpr size_t WS_CTL = 0, CTL_ZERO_BYTES = 1 * MiB;
constexpr size_t WS_MOD = 1 * MiB;
constexpr size_t WS_MODP = 3 * MiB;
constexpr size_t WS_POOLWT = 33 * MiB;
constexpr size_t WS_BT1 = 34 * MiB, BT1_L = (size_t)N1 * D * 2;
constexpr size_t WS_BT2 = 282 * MiB, BT2_L = (size_t)4 * D * BRW * 2;
constexpr size_t WS_BT3 = 314 * MiB, BT3_L = (size_t)D * D * 2;
constexpr size_t WS_BT4 = 346 * MiB, BT4_L = (size_t)N4 * D * 2;
constexpr size_t WS_BT5 = 522 * MiB, BT5_L = (size_t)D * DFF * 2;
constexpr size_t WS_X = 610 * MiB;
constexpr size_t WS_HN = 676 * MiB;
constexpr size_t WS_P = 709 * MiB;
constexpr size_t WS_GATES = 833 * MiB;
constexpr size_t WS_YS = 965 * MiB;
constexpr size_t WS_OG = 998 * MiB;
constexpr size_t WS_LSE = 1022 * MiB;
constexpr size_t WS_MERGED = 1023 * MiB;
constexpr size_t WS_ACC = 1056 * MiB;
constexpr size_t WS_H = 1120 * MiB;
constexpr size_t WS_END = 1211 * MiB;
static_assert(WS_BT1 + 4 * BT1_L <= WS_BT2 && WS_BT2 + 4 * BT2_L <= WS_BT3 && WS_BT3 + 4 * BT3_L <= WS_BT4 && WS_BT4 + 4 * BT4_L <= WS_BT5 && WS_BT5 + 4 * BT5_L <= WS_X, "ws map (weights)");
static_assert(WS_X + (size_t)MPAD * D * 4 <= WS_HN && WS_HN + (size_t)MPAD * D * 2 <= WS_P && WS_P + (size_t)MPAD * NIN * 2 <= WS_GATES && WS_GATES + (size_t)MPAD * NGATE * 2 <= WS_YS, "ws map (act 1)");
static_assert(WS_YS + (size_t)MPAD * D * 2 <= WS_OG && WS_OG + (size_t)3 * MP * BRW * 2 <= WS_LSE && WS_LSE + (size_t)3 * MP * 4 * 4 <= WS_MERGED && WS_MERGED + (size_t)MPAD * D * 2 <= WS_ACC, "ws map (act 2)");
static_assert(WS_ACC + (size_t)256 * 32 * 512 * 16 <= WS_H && WS_H + (size_t)MPAD * DFF * 2 <= WS_END, "ws map (act 3)");
static_assert(WS_MOD + (size_t)DEPTH * NBB * 6 * D * 4 <= WS_MODP && WS_MODP + (size_t)16 * DEPTH * NBB * 6 * D * 4 <= WS_POOLWT, "ws map (mod)");
constexpr int CW_BAR = 4096;

constexpr int RING_BYTES = 131072;
constexpr int LDSCTL_OFF = RING_BYTES, MISC_OFF = LDSCTL_OFF + 320;
constexpr int LDS_BYTES = 147456;

__device__ __forceinline__ unsigned cvt_pk_bf16(float lo, float hi) { unsigned r; asm("v_cvt_pk_bf16_f32 %0, %1, %2" : "=v"(r) : "v"(lo), "v"(hi)); return r; }
__device__ __forceinline__ float bflo(unsigned u) { return __uint_as_float(u << 16); }
__device__ __forceinline__ float bfhi(unsigned u) { return __uint_as_float(u & 0xffff0000u); }
__device__ __forceinline__ float bf1(bf16_t b) { return __uint_as_float(((unsigned)b) << 16); }
__device__ __forceinline__ void unpack8(const u32x4 w, float (&f)[8]) { f[0] = bflo(w.x); f[1] = bfhi(w.x); f[2] = bflo(w.y); f[3] = bfhi(w.y); f[4] = bflo(w.z); f[5] = bfhi(w.z); f[6] = bflo(w.w); f[7] = bfhi(w.w); }
__device__ __forceinline__ u32x4 pack8(const float (&f)[8]) { u32x4 w; w.x = cvt_pk_bf16(f[0], f[1]); w.y = cvt_pk_bf16(f[2], f[3]); w.z = cvt_pk_bf16(f[4], f[5]); w.w = cvt_pk_bf16(f[6], f[7]); return w; }
__device__ __forceinline__ float wave_sum(float v) {
#pragma unroll
    for (int o = 1; o < 64; o <<= 1) v += __shfl_xor(v, o);
    return v;
}
__device__ __forceinline__ float wave_max(float v) {
#pragma unroll
    for (int o = 1; o < 64; o <<= 1) v = fmaxf(v, __shfl_xor(v, o));
    return v;
}
__device__ __forceinline__ float sigmoidf_(float x) { return 1.0f / (1.0f + __expf(-x)); }
__device__ __forceinline__ float gelu_tanh(float x) { const float u = 0.7978845608028654f * (x + 0.044715f * x * x * x); return x / (1.0f + __expf(-2.0f * u)); }

__constant__ unsigned char BKT[3][132] = {
{0,1,2,3,4,5,6,7,8,9,10,11,12,13,14,15,16,16,16,16,16,16,17,17,17,17,17,17,17,17,18,18,18,18,18,18,18,18,18,18,19,19,19,19,19,19,19,19,19,19,19,19,19,19,20,20,20,20,20,20,20,20,20,20,20,20,20,20,20,20,20,20,20,21,21,21,21,21,21,21,21,21,21,21,21,21,21,21,21,21,21,21,21,21,21,21,21,21,21,22,22,22,22,22,22,22,22,22,22,22,22,22,22,22,22,22,22,22,22,22,22,22,22,22,22,22,22,22,22,0,0,0},
{0,4,8,12,16,16,17,17,18,18,19,19,19,19,20,20,20,20,20,21,21,21,21,21,21,22,22,22,22,22,22,22,22,22,23,23,23,23,23,23,23,23,23,23,23,23,24,24,24,24,24,24,24,24,24,24,24,24,24,24,24,24,25,25,25,25,25,25,25,25,25,25,25,25,25,25,25,25,25,25,25,25,25,26,26,26,26,26,26,26,26,26,26,26,26,26,26,26,26,26,26,26,26,26,26,26,26,26,26,26,26,26,26,27,27,27,27,27,27,27,27,27,27,27,27,27,27,27,27,0,0,0},
{0,16,18,19,20,21,21,22,22,23,23,23,24,24,24,24,25,25,25,25,25,26,26,26,26,26,26,26,26,27,27,27,27,27,27,27,27,27,27,28,28,28,28,28,28,28,28,28,28,28,28,28,29,29,29,29,29,29,29,29,29,29,29,29,29,29,29,29,29,29,30,30,30,30,30,30,30,30,30,30,30,30,30,30,30,30,30,30,30,30,30,30,30,30,30,31,31,31,31,31,31,31,31,31,31,31,31,31,31,31,31,31,31,31,31,31,31,31,31,31,31,31,31,31,31,31,31,31,31,0,0,0}};

#define XB_TMO      128
#define XB_XCNT(j)  (256  + 64 * (j))
#define XB_XSUB(j)  (1280 + 64 * (j))
#define XB_XGEN(j)  (2304 + 64 * (j))
#define XB_TOP      3328
#define XB_TOPGEN   3392
#define XCD_BAR_WORDS 3456
#define XB_SPIN_CAP (1u << 18)
__device__ __forceinline__ unsigned xb_ld(unsigned* p)              { return __hip_atomic_load(p, __ATOMIC_RELAXED, __HIP_MEMORY_SCOPE_AGENT); }
__device__ __forceinline__ unsigned xb_add(unsigned* p, unsigned v) { return __hip_atomic_fetch_add(p, v, __ATOMIC_RELAXED, __HIP_MEMORY_SCOPE_AGENT); }
__device__ __forceinline__ unsigned xb_xcc_id() { return (unsigned)__builtin_amdgcn_s_getreg((3 << 11) | 20) & 0xFu; }
#define XB_SPIN(cond, bar) do { unsigned _sp = 0; while (cond) { __builtin_amdgcn_s_sleep(1); \
    if ((++_sp & 255u) == 0u) { if (xb_ld(&(bar)[XB_TMO])) break; if (_sp > XB_SPIN_CAP) { atomicAdd(&(bar)[XB_TMO], 1u); break; } } } } while (0)
struct XcdBarrier { unsigned* bar; unsigned x; volatile LAS unsigned* st; };
__device__ __forceinline__ XcdBarrier xcd_barrier_post(unsigned* bar, volatile LAS unsigned* st) {
    XcdBarrier b; b.bar = bar; b.x = xb_xcc_id(); b.st = st;
    if (threadIdx.x == 0) (void)xb_add(&bar[XB_XCNT(b.x)], 1u);
    return b;
}
__device__ __forceinline__ void xcd_barrier_complete(unsigned* bar, unsigned x, unsigned& nloc, unsigned& nx) {
    const unsigned G = gridDim.x * gridDim.y * gridDim.z;
    unsigned sum, cnt, mine, sp = 0u;
    for (;;) {
        sum = 0u; cnt = 0u; mine = 0u;
#pragma unroll
        for (unsigned j = 0; j < 16; ++j) { const unsigned c = xb_ld(&bar[XB_XCNT(j)]); sum += c; cnt += (c > 0u) ? 1u : 0u; mine = (j == x) ? c : mine; }
        if (sum == G) break;
        __builtin_amdgcn_s_sleep(1);
        if ((++sp & 255u) == 0u) { if (xb_ld(&bar[XB_TMO])) break; if (sp > XB_SPIN_CAP) { atomicAdd(&bar[XB_TMO], 1u); break; } }
    }
    nloc = mine > 0u ? mine : 1u; nx = cnt > 0u ? cnt : 1u;
}
__device__ __forceinline__ void xcd_barrier(const XcdBarrier& b) {
    asm volatile("s_waitcnt vmcnt(0)" ::: "memory");
    __syncthreads();
    if (threadIdx.x == 0) {
        unsigned* bar = b.bar;
        __builtin_amdgcn_s_waitcnt(0);
        unsigned nloc = b.st[0], nx = b.st[1];
        if (nloc == 0u) { xcd_barrier_complete(bar, b.x, nloc, nx); b.st[0] = nloc; b.st[1] = nx; }
        const unsigned old = xb_add(&bar[XB_XSUB(b.x)], 1u);
        const unsigned gen = old / nloc;
        if (old + 1u == (gen + 1u) * nloc) {
            __builtin_amdgcn_fence(__ATOMIC_RELEASE, "agent");
            asm volatile("s_waitcnt vmcnt(0)" ::: "memory");
            const unsigned og = xb_add(&bar[XB_TOP], 1u);
            const unsigned tg = og / nx;
            if (og + 1u == (tg + 1u) * nx) xb_add(&bar[XB_TOPGEN], 1u);
            else XB_SPIN(xb_ld(&bar[XB_TOPGEN]) == tg, bar);
            __builtin_amdgcn_fence(__ATOMIC_ACQUIRE, "agent");
            xb_add(&bar[XB_XGEN(b.x)], 1u);
            asm volatile("s_waitcnt vmcnt(0)" ::: "memory");
        } else {
            XB_SPIN(xb_ld(&bar[XB_XGEN(b.x)]) == gen, bar);
            __builtin_amdgcn_fence(__ATOMIC_ACQUIRE, "agent");
            asm volatile("s_waitcnt vmcnt(0)" ::: "memory");
        }
    }
    __syncthreads();
}

namespace pg8 {
constexpr int BM = 256, BK = 64, HALF = 128, HTB = HALF * BK * 2, STAGE_BYTES = 8 * HTB, NXCD = 8, WGM = 8;
__host__ __device__ __forceinline__ int lds_byte(int r, int c) { const int st = (r >> 4) * 2 + (c >> 5), rr = r & 15, cc = c & 31, ob = rr * 64 + cc * 2; return st * 1024 + (ob ^ (((ob >> 9) & 1) << 5)); }
__host__ __device__ __forceinline__ void stage_rc(int b, int& R, int& C) { const int st = b / 1024, sb = b % 1024, swz = sb ^ (((sb >> 9) & 1) << 5); R = (st >> 1) * 16 + swz / 64; C = (st & 1) * 32 + (swz % 64) / 2; }
__host__ __device__ __forceinline__ int perm32(int rho) { const int n = rho >> 4, i = rho & 15; return 8 * (i >> 2) + 4 * n + (i & 3); }

struct Unit { int pm, pn, tag; size_t aoff, boff; };
struct Gemm { const bf16_t* A; const bf16_t* Bt; int lda, ldb, K; };

struct StaticOrder {
    int nM, nN, nwg, G, c; size_t astep, bstep;
    __device__ void init(int nM_, int nN_, int G_, int c_, int lda, int ldb) { nM = nM_; nN = nN_; nwg = nM * nN; G = G_; c = c_; astep = (size_t)BM * lda * 2; bstep = (size_t)BM * ldb * 2; }
    __device__ bool next(int i, Unit& u) const {
        const long L = (long)i * G + c; if (L >= nwg) return false;
        int wgid = (int)L; { const int q = nwg / NXCD, r = nwg % NXCD, xcd = wgid % NXCD, off = wgid / NXCD; wgid = (xcd < r ? xcd * (q + 1) : r * (q + 1) + (xcd - r) * q) + off; }
        const int nig = WGM * nN, gid = wgid / nig, fm = gid * WGM, gsz = (nM - fm) < WGM ? (nM - fm) : WGM;
        u.pm = fm + ((wgid % nig) % gsz); u.pn = (wgid % nig) / gsz; u.tag = 0; u.aoff = (size_t)u.pm * astep; u.boff = (size_t)u.pn * bstep; return true;
    }
};
template <class Epi, class Sched>
__device__ __forceinline__ void gemm_phase(LAS unsigned char* lds, const Gemm g, const Sched& S, const Epi& E) {
    int lane = threadIdx.x & 63, wid = __builtin_amdgcn_readfirstlane(threadIdx.x >> 6); asm volatile("" : "+v"(lane)); asm volatile("" : "+s"(wid));
    const int tid = wid * 64 + lane, wr = wid >> 2, wc = wid & 3, fr = lane & 15, fq = lane >> 4;
    const int K = g.K, nt = K / BK;
    unsigned voffA[2], voffB[2];
#pragma unroll
    for (int i = 0; i < 2; ++i) { int R, C; stage_rc(tid * 16 + i * 8192, R, C); const int Rb = Epi::PERM ? ((R & ~31) + perm32(R & 31)) : R;
        voffA[i] = (unsigned)(R * g.lda + C) * 2u; voffB[i] = (unsigned)(Rb * g.ldb + C) * 2u; }
    const size_t kstep = (size_t)(BK * 2);
    const size_t hA = (size_t)HALF * g.lda * 2, hB = (size_t)HALF * g.ldb * 2;
    const unsigned ldsw = (unsigned)wid * 1024u;
    const int aoff = lds_byte(wr * 64 + fr, fq * 8), boff = lds_byte(wc * 32 + fr, fq * 8);
#define PG8_SA(b, h) (((b) * 2 + (h)) * HTB)
#define PG8_SB(b, h) ((4 + (b) * 2 + (h)) * HTB)
#define PG8_STAGE(bufoff, gbase, voff) do { _Pragma("unroll") for (int _i = 0; _i < 2; ++_i) \
        __builtin_amdgcn_global_load_lds((const unsigned*)((const char*)(gbase) + (voff)[_i]), (LAS unsigned*)(lds + (bufoff) + ldsw + _i * 8192), 16, 0, 0); } while (0)
#define PG8_LDA(dst, b, h) do { _Pragma("unroll") for (int m = 0; m < 4; ++m) _Pragma("unroll") for (int k = 0; k < 2; ++k) dst[m][k] = *(const LAS bf16x8*)(lds + PG8_SA(b, h) + aoff + m * 2048 + k * 1024); } while (0)
#define PG8_LDB(dst, b, h) do { _Pragma("unroll") for (int n = 0; n < 2; ++n) _Pragma("unroll") for (int k = 0; k < 2; ++k) dst[n][k] = *(const LAS bf16x8*)(lds + PG8_SB(b, h) + boff + n * 2048 + k * 1024); } while (0)
#define PG8_MMA(ai, bj, At, Bt) do { __builtin_amdgcn_s_setprio(1); _Pragma("unroll") for (int m = 0; m < 4; ++m) _Pragma("unroll") for (int n = 0; n < 2; ++n) _Pragma("unroll") for (int k = 0; k < 2; ++k) \
        acc[ai][bj][m][n] = __builtin_amdgcn_mfma_f32_16x16x32_bf16(Bt[n][k], At[m][k], acc[ai][bj][m][n], 0, 0, 0); __builtin_amdgcn_s_setprio(0); } while (0)
#define PG8_WAIT_V(n) asm volatile("s_waitcnt vmcnt(" #n ")" ::: "memory")
#define PG8_WAIT_L(n) asm volatile("s_waitcnt lgkmcnt(" #n ")" ::: "memory")
#define PG8_BAR __builtin_amdgcn_s_barrier()
#define PG8_SCHED __builtin_amdgcn_sched_barrier(0)
    Unit cur, nxt; int ui = 0;
    if (!S.next(0, cur)) return;
    f32x4 acc[2][2][4][2];
#pragma unroll
    for (int a = 0; a < 2; ++a)
#pragma unroll
        for (int b = 0; b < 2; ++b)
#pragma unroll
            for (int m = 0; m < 4; ++m)
#pragma unroll
                for (int n = 0; n < 2; ++n) acc[a][b][m][n] = (f32x4){0.f, 0.f, 0.f, 0.f};
    bf16x8 At[4][2], B0[2][2], B1[2][2];
    const char* cA = (const char*)g.A + cur.aoff; const char* cB = (const char*)g.Bt + cur.boff;
    PG8_STAGE(PG8_SB(0, 0), cB, voffB); PG8_STAGE(PG8_SB(0, 1), cB + hB, voffB); PG8_STAGE(PG8_SA(0, 0), cA, voffA); PG8_STAGE(PG8_SA(0, 1), cA + hA, voffA);
    if (wr == 1) PG8_BAR;
    PG8_WAIT_V(2); PG8_BAR;
    PG8_STAGE(PG8_SB(1, 0), cB + kstep, voffB); PG8_STAGE(PG8_SA(1, 0), cA + kstep, voffA); PG8_STAGE(PG8_SB(1, 1), cB + hB + kstep, voffB);
    PG8_WAIT_V(6); PG8_BAR;
    for (;;) {
        const bool has_next = S.next(ui + 1, nxt);
        const char* nA = has_next ? (const char*)g.A + nxt.aoff : cA; const char* nB = has_next ? (const char*)g.Bt + nxt.boff : cB;
        for (int t = 0; t < nt; t += 2) {
            const bool last = (t == nt - 2);
            const char* a1 = cA + (size_t)(t + 1) * kstep;
            const char* a2 = last ? nA : cA + (size_t)(t + 2) * kstep; const char* b2 = last ? nB : cB + (size_t)(t + 2) * kstep;
            const char* a3 = a2 + kstep; const char* b3 = b2 + kstep;
            PG8_LDB(B0, 0, 0); PG8_LDB(B1, 0, 1); PG8_SCHED; PG8_LDA(At, 0, 0); PG8_STAGE(PG8_SA(1, 1), a1 + hA, voffA);
            PG8_WAIT_V(8); PG8_WAIT_L(0); PG8_BAR; PG8_MMA(0, 0, At, B0); PG8_MMA(0, 1, At, B1); PG8_BAR; PG8_SCHED;
            PG8_LDA(At, 0, 1); PG8_STAGE(PG8_SB(0, 0), b2, voffB); PG8_STAGE(PG8_SB(0, 1), b2 + hB, voffB); PG8_STAGE(PG8_SA(0, 0), a2, voffA);
            PG8_WAIT_V(8); PG8_WAIT_L(0); PG8_BAR; PG8_MMA(1, 0, At, B0); PG8_MMA(1, 1, At, B1); PG8_BAR; PG8_SCHED;
            PG8_LDB(B0, 1, 0); PG8_LDB(B1, 1, 1); PG8_SCHED; PG8_LDA(At, 1, 0); PG8_STAGE(PG8_SA(0, 1), a2 + hA, voffA);
            PG8_WAIT_V(8); PG8_WAIT_L(0); PG8_BAR; PG8_MMA(0, 0, At, B0); PG8_MMA(0, 1, At, B1); PG8_BAR; PG8_SCHED;
            PG8_LDA(At, 1, 1); PG8_STAGE(PG8_SB(1, 0), b3, voffB); PG8_STAGE(PG8_SB(1, 1), b3 + hB, voffB); PG8_STAGE(PG8_SA(1, 0), a3, voffA);
            PG8_WAIT_V(8); PG8_WAIT_L(0); PG8_BAR; PG8_MMA(1, 0, At, B0); PG8_MMA(1, 1, At, B1); PG8_BAR; PG8_SCHED;
        }
        if (wr == 0) PG8_BAR;
        E(acc, cur, wr, wc, fr, fq);
        if (!has_next) break;
#pragma unroll
        for (int a = 0; a < 2; ++a)
#pragma unroll
            for (int b = 0; b < 2; ++b)
#pragma unroll
                for (int m = 0; m < 4; ++m)
#pragma unroll
                    for (int n = 0; n < 2; ++n) acc[a][b][m][n] = (f32x4){0.f, 0.f, 0.f, 0.f};
        cur = nxt; cA = nA; cB = nB; ++ui;
        if (wr == 1) PG8_BAR;
    }
    PG8_WAIT_V(0);
    PG8_BAR;
#undef PG8_SA
#undef PG8_SB
#undef PG8_STAGE
#undef PG8_LDA
#undef PG8_LDB
#undef PG8_MMA
#undef PG8_WAIT_V
#undef PG8_WAIT_L
#undef PG8_BAR
#undef PG8_SCHED
}


__device__ __forceinline__ void gemm_gated_phase(LAS unsigned char* lds, const bf16_t* A, const bf16_t* Bt, const bf16_t* G, bf16_t* O, int ntiles, int Gsz, int vc) {
    int lane = threadIdx.x & 63, wid = __builtin_amdgcn_readfirstlane(threadIdx.x >> 6); asm volatile("" : "+v"(lane)); asm volatile("" : "+s"(wid));
    const int tid = wid * 64 + lane, wr = wid >> 2, wc = wid & 3, fr = lane & 15, fq = lane >> 4;
    constexpr int K = D, nt = K / BK;
    unsigned voffA[2], voffB[2];
#pragma unroll
    for (int i = 0; i < 2; ++i) { int R, C; stage_rc(tid * 16 + i * 8192, R, C); const int Rb = (R & ~31) + perm32(R & 31);
        voffA[i] = (unsigned)(R * K + C) * 2u; voffB[i] = (unsigned)(Rb * K + C) * 2u; }
    const size_t kstep = (size_t)(BK * 2), hA = (size_t)HALF * K * 2;
    const unsigned ldsw = (unsigned)wid * 1024u;
    const int aoff = lds_byte(wr * 64 + fr, fq * 8), boff = lds_byte(wc * 32 + fr, fq * 8);
#define PG8_SA(b, h) (((b) * 2 + (h)) * HTB)
#define PG8_SB(b) ((4 + (b) * 2) * HTB)
#define PG8_STAGE(bufoff, gbase, voff) do { _Pragma("unroll") for (int _i = 0; _i < 2; ++_i) \
        __builtin_amdgcn_global_load_lds((const unsigned*)((const char*)(gbase) + (voff)[_i]), (LAS unsigned*)(lds + (bufoff) + ldsw + _i * 8192), 16, 0, 0); } while (0)
#define PG8_LDA(dst, b, h) do { _Pragma("unroll") for (int m = 0; m < 4; ++m) _Pragma("unroll") for (int k = 0; k < 2; ++k) dst[m][k] = *(const LAS bf16x8*)(lds + PG8_SA(b, h) + aoff + m * 2048 + k * 1024); } while (0)
#define PG8_LDB(dst, b) do { _Pragma("unroll") for (int n = 0; n < 2; ++n) _Pragma("unroll") for (int k = 0; k < 2; ++k) dst[n][k] = *(const LAS bf16x8*)(lds + PG8_SB(b) + boff + n * 2048 + k * 1024); } while (0)
#define PG8_MMA(ai, At, Bt_) do { __builtin_amdgcn_s_setprio(1); _Pragma("unroll") for (int m = 0; m < 4; ++m) _Pragma("unroll") for (int n = 0; n < 2; ++n) _Pragma("unroll") for (int k = 0; k < 2; ++k) \
        acc[ai][m][n] = __builtin_amdgcn_mfma_f32_16x16x32_bf16(Bt_[n][k], At[m][k], acc[ai][m][n], 0, 0, 0); __builtin_amdgcn_s_setprio(0); } while (0)
#define PG8_WAIT_V(n) asm volatile("s_waitcnt vmcnt(" #n ")" ::: "memory")
#define PG8_WAIT_L(n) asm volatile("s_waitcnt lgkmcnt(" #n ")" ::: "memory")
#define PG8_BAR __builtin_amdgcn_s_barrier()
#define PG8_SCHED __builtin_amdgcn_sched_barrier(0)
    int T = vc; if (T >= ntiles) return;
    f32x4 acc[2][4][2], mg[2][4][2];
#pragma unroll
    for (int a = 0; a < 2; ++a)
#pragma unroll
        for (int m = 0; m < 4; ++m)
#pragma unroll
            for (int n = 0; n < 2; ++n) { acc[a][m][n] = (f32x4){0.f, 0.f, 0.f, 0.f}; mg[a][m][n] = (f32x4){0.f, 0.f, 0.f, 0.f}; }
    bf16x8 At[4][2], B0[2][2];
    const char* cA = (const char*)A + (size_t)(T >> 4) * (2 * hA); const char* cB = (const char*)Bt + (size_t)(T & 15) * hA;
    PG8_STAGE(PG8_SB(0), cB, voffB); PG8_STAGE(PG8_SA(0, 0), cA, voffA); PG8_STAGE(PG8_SA(0, 1), cA + hA, voffA);
    if (wr == 1) PG8_BAR;
    PG8_WAIT_V(2); PG8_BAR;
    PG8_STAGE(PG8_SB(1), cB + kstep, voffB); PG8_STAGE(PG8_SA(1, 0), cA + kstep, voffA);
    PG8_WAIT_V(4); PG8_BAR;
    for (;;) {
        const int Tn = T + Gsz; const bool has_next = Tn < ntiles;
        const char* nA = has_next ? (const char*)A + (size_t)(Tn >> 4) * (2 * hA) : cA; const char* nB = has_next ? (const char*)Bt + (size_t)(Tn & 15) * hA : cB;
        const int row0 = (T >> 4) * BM + wr * 64 + fr, cw = (T & 15) * HALF + wc * 32 + 8 * fq;
        for (int t = 0; t < nt; t += 2) {
            const bool last = (t == nt - 2);
            const char* a1 = cA + (size_t)(t + 1) * kstep;
            const char* a2 = last ? nA : cA + (size_t)(t + 2) * kstep; const char* b2 = last ? nB : cB + (size_t)(t + 2) * kstep;
            const char* a3 = a2 + kstep; const char* b3 = b2 + kstep;
            PG8_LDB(B0, 0); PG8_SCHED; PG8_LDA(At, 0, 0); PG8_STAGE(PG8_SA(1, 1), a1 + hA, voffA);
            PG8_WAIT_V(6); PG8_WAIT_L(0); PG8_BAR; PG8_MMA(0, At, B0); PG8_BAR; PG8_SCHED;
            PG8_LDA(At, 0, 1); PG8_STAGE(PG8_SB(0), b2, voffB); PG8_STAGE(PG8_SA(0, 0), a2, voffA);
            PG8_WAIT_V(6); PG8_WAIT_L(0); PG8_BAR; PG8_MMA(1, At, B0); PG8_BAR; PG8_SCHED;
            PG8_LDB(B0, 1); PG8_SCHED; PG8_LDA(At, 1, 0); PG8_STAGE(PG8_SA(0, 1), a2 + hA, voffA);
            PG8_WAIT_V(6); PG8_WAIT_L(0); PG8_BAR; PG8_MMA(0, At, B0); PG8_BAR; PG8_SCHED;
            PG8_LDA(At, 1, 1); PG8_STAGE(PG8_SB(1), b3, voffB); PG8_STAGE(PG8_SA(1, 0), a3, voffA);
            PG8_WAIT_V(6); PG8_WAIT_L(0); PG8_BAR; PG8_MMA(1, At, B0); PG8_BAR; PG8_SCHED;
            if ((t & 6) == 6) {
                const bf16_t* gp = G + (size_t)row0 * NGATE + (size_t)(t >> 3) * D + cw;
                u32x4 gws[8];
#pragma unroll
                for (int q = 0; q < 8; ++q) gws[q] = *(const u32x4*)(gp + (size_t)((q >> 2) * HALF + (q & 3) * 16) * NGATE);
                asm volatile("" : "+v"(gws[0]), "+v"(gws[1]), "+v"(gws[2]), "+v"(gws[3]), "+v"(gws[4]), "+v"(gws[5]), "+v"(gws[6]), "+v"(gws[7]));
#pragma unroll
                for (int ai = 0; ai < 2; ++ai)
#pragma unroll
                    for (int m = 0; m < 4; ++m) { const u32x4 gw = gws[ai * 4 + m];
                        mg[ai][m][0] += acc[ai][m][0] * (f32x4){bflo(gw.x), bfhi(gw.x), bflo(gw.y), bfhi(gw.y)};
                        mg[ai][m][1] += acc[ai][m][1] * (f32x4){bflo(gw.z), bfhi(gw.z), bflo(gw.w), bfhi(gw.w)};
                        acc[ai][m][0] = (f32x4){0.f, 0.f, 0.f, 0.f}; acc[ai][m][1] = (f32x4){0.f, 0.f, 0.f, 0.f}; }
            }
        }
#pragma unroll
        for (int ai = 0; ai < 2; ++ai)
#pragma unroll
            for (int m = 0; m < 4; ++m) { const f32x4 v0 = mg[ai][m][0], v1 = mg[ai][m][1];
                u32x4 w; w.x = cvt_pk_bf16(v0[0], v0[1]); w.y = cvt_pk_bf16(v0[2], v0[3]); w.z = cvt_pk_bf16(v1[0], v1[1]); w.w = cvt_pk_bf16(v1[2], v1[3]);
                *(u32x4*)(O + (size_t)(row0 + ai * HALF + m * 16) * D + cw) = w;
                mg[ai][m][0] = (f32x4){0.f, 0.f, 0.f, 0.f}; mg[ai][m][1] = (f32x4){0.f, 0.f, 0.f, 0.f}; }
        if (!has_next) break;
        T = Tn; cA = nA; cB = nB;
    }
    PG8_WAIT_V(0);
    if (wr == 0) PG8_BAR;
    PG8_BAR;
#undef PG8_SA
#undef PG8_SB
#undef PG8_STAGE
#undef PG8_LDA
#undef PG8_LDB
#undef PG8_MMA
#undef PG8_WAIT_V
#undef PG8_WAIT_L
#undef PG8_BAR
#undef PG8_SCHED
}

struct Epi1 {
    static constexpr bool PERM = true;
    bf16_t* P; bf16_t* G; const float* bg;
    __device__ __forceinline__ void operator()(const f32x4 (&acc)[2][2][4][2], const Unit& u, int wr, int wc, int fr, int fq) const {
        const int row0 = u.pm * BM + wr * 64 + fr, ct = u.pn * BM, cw = wc * 32 + 8 * fq;
        if (ct < NIN) {
            const bool gelu = ct < 1024;
#pragma unroll
            for (int ai = 0; ai < 2; ++ai)
#pragma unroll
                for (int m = 0; m < 4; ++m) { bf16_t* rowp = P + (size_t)(row0 + ai * HALF + m * 16) * NIN + ct + cw;
#pragma unroll
                    for (int bj = 0; bj < 2; ++bj) { f32x4 v0 = acc[ai][bj][m][0], v1 = acc[ai][bj][m][1];
                        if (gelu) {
#pragma unroll
                            for (int j = 0; j < 4; ++j) { v0[j] = gelu_tanh(v0[j]); v1[j] = gelu_tanh(v1[j]); } }
                        u32x4 w; w.x = cvt_pk_bf16(v0[0], v0[1]); w.y = cvt_pk_bf16(v0[2], v0[3]); w.z = cvt_pk_bf16(v1[0], v1[1]); w.w = cvt_pk_bf16(v1[2], v1[3]);
                        *(u32x4*)(rowp + bj * HALF) = w; } }
        } else {
            const int cg = ct - NIN + cw;
            f32x4 bv[2][2];
#pragma unroll
            for (int bj = 0; bj < 2; ++bj)
#pragma unroll
                for (int n = 0; n < 2; ++n) bv[bj][n] = *(const f32x4*)(bg + cg + bj * HALF + 4 * n);
#pragma unroll
            for (int ai = 0; ai < 2; ++ai)
#pragma unroll
                for (int m = 0; m < 4; ++m) { bf16_t* rowp = G + (size_t)(row0 + ai * HALF + m * 16) * NGATE + cg;
#pragma unroll
                    for (int bj = 0; bj < 2; ++bj) { f32x4 v0 = acc[ai][bj][m][0] + bv[bj][0], v1 = acc[ai][bj][m][1] + bv[bj][1];
#pragma unroll
                        for (int j = 0; j < 4; ++j) { v0[j] = sigmoidf_(v0[j]); v1[j] = sigmoidf_(v1[j]); }
                        u32x4 w; w.x = cvt_pk_bf16(v0[0], v0[1]); w.y = cvt_pk_bf16(v0[2], v0[3]); w.z = cvt_pk_bf16(v1[0], v1[1]); w.w = cvt_pk_bf16(v1[2], v1[3]);
                        *(u32x4*)(rowp + bj * HALF) = w; } }
        }
    }
};
struct EpiRes {
    static constexpr bool PERM = false;
    float* X; const float* modl; int jg;
    __device__ __forceinline__ void operator()(const f32x4 (&acc)[2][2][4][2], const Unit& u, int wr, int wc, int fr, int fq) const {
        const int row0 = u.pm * BM + wr * 64 + fr, col0 = u.pn * BM + wc * 32 + 4 * fq, bb = u.pm >> 4;
        const float* gp = modl + (size_t)(bb * 6 + jg) * D + col0;
        f32x4 gv[2][2];
#pragma unroll
        for (int bj = 0; bj < 2; ++bj)
#pragma unroll
            for (int n = 0; n < 2; ++n) gv[bj][n] = *(const f32x4*)(gp + bj * HALF + n * 16);
#pragma unroll
        for (int ai = 0; ai < 2; ++ai) {
            float* xp = X + (size_t)(row0 + ai * HALF) * D + col0;
            f32x4 xv[4][2][2];
#pragma unroll
            for (int m = 0; m < 4; ++m)
#pragma unroll
                for (int bj = 0; bj < 2; ++bj)
#pragma unroll
                    for (int n = 0; n < 2; ++n) xv[m][bj][n] = *(const f32x4*)(xp + (size_t)(m * 16) * D + bj * HALF + n * 16);
            asm volatile("" : "+v"(xv[0][0][0]), "+v"(xv[0][0][1]), "+v"(xv[0][1][0]), "+v"(xv[0][1][1]), "+v"(xv[1][0][0]), "+v"(xv[1][0][1]), "+v"(xv[1][1][0]), "+v"(xv[1][1][1]),
                             "+v"(xv[2][0][0]), "+v"(xv[2][0][1]), "+v"(xv[2][1][0]), "+v"(xv[2][1][1]), "+v"(xv[3][0][0]), "+v"(xv[3][0][1]), "+v"(xv[3][1][0]), "+v"(xv[3][1][1]));
#pragma unroll
            for (int m = 0; m < 4; ++m)
#pragma unroll
                for (int bj = 0; bj < 2; ++bj)
#pragma unroll
                    for (int n = 0; n < 2; ++n) *(f32x4*)(xp + (size_t)(m * 16) * D + bj * HALF + n * 16) = xv[m][bj][n] + gv[bj][n] * acc[ai][bj][m][n];
            asm volatile("" ::: "memory");
        }
    }
};
struct EpiSwi {
    static constexpr bool PERM = true;
    bf16_t* H;
    __device__ __forceinline__ void operator()(const f32x4 (&acc)[2][2][4][2], const Unit& u, int wr, int wc, int fr, int fq) const {
        const int row0 = u.pm * BM + wr * 64 + fr, c0 = u.pn * HALF + wc * 32 + 8 * fq;
#pragma unroll
        for (int ai = 0; ai < 2; ++ai)
#pragma unroll
            for (int m = 0; m < 4; ++m) { bf16_t* rowp = H + (size_t)(row0 + ai * HALF + m * 16) * DFF + c0;
                f32x4 v0, v1;
#pragma unroll
                for (int j = 0; j < 4; ++j) { const float a0 = acc[ai][0][m][0][j], a1 = acc[ai][0][m][1][j]; v0[j] = a0 * sigmoidf_(a0) * acc[ai][1][m][0][j]; v1[j] = a1 * sigmoidf_(a1) * acc[ai][1][m][1][j]; }
                u32x4 w; w.x = cvt_pk_bf16(v0[0], v0[1]); w.y = cvt_pk_bf16(v0[2], v0[3]); w.z = cvt_pk_bf16(v1[0], v1[1]); w.w = cvt_pk_bf16(v1[2], v1[3]);
                *(u32x4*)rowp = w; }
    }
};
}

enum { I_XP = 0, I_XS, I_CP, I_CS, I_CB1, I_CB2, I_CB3, I_CPOOL, I_CCONV, I_LN1G, I_LN2G, I_WADA, I_BADA, I_WIN, I_WGATE, I_BGATE, I_ALNG, I_ALNB, I_AWS, I_ABS, I_RELB, I_POOLW, I_POOLB, I_POOLS, I_CONVW, I_WBR, I_WOUT, I_W1, I_W3, I_W2, I_FING };
__device__ __forceinline__ const float* inp(int i) {
    const __attribute__((address_space(4))) char* kp = (const __attribute__((address_space(4))) char*)__builtin_amdgcn_kernarg_segment_ptr();
    return *(const float* const volatile __attribute__((address_space(4)))*)(kp + 8 * i);
}
struct Frame {
    LAS unsigned char* lds;
    int tid, lane, wave, vcu, G;
    float* out; unsigned char* ws;
    __device__ __forceinline__ float* MOD() const { return (float*)(ws + WS_MOD); }
    __device__ __forceinline__ float* MODP() const { return (float*)(ws + WS_MODP); }
    __device__ __forceinline__ float* X() const { return (float*)(ws + WS_X); }
    __device__ __forceinline__ float* LSE() const { return (float*)(ws + WS_LSE); }
    __device__ __forceinline__ float* ACC() const { return (float*)(ws + WS_ACC); }
    __device__ __forceinline__ bf16_t* POOLWT() const { return (bf16_t*)(ws + WS_POOLWT); }
    __device__ __forceinline__ bf16_t* HN() const { return (bf16_t*)(ws + WS_HN); }
    __device__ __forceinline__ bf16_t* P() const { return (bf16_t*)(ws + WS_P); }
    __device__ __forceinline__ bf16_t* GATES() const { return (bf16_t*)(ws + WS_GATES); }
    __device__ __forceinline__ bf16_t* YS() const { return (bf16_t*)(ws + WS_YS); }
    __device__ __forceinline__ bf16_t* OG() const { return (bf16_t*)(ws + WS_OG); }
    __device__ __forceinline__ bf16_t* MERGED() const { return (bf16_t*)(ws + WS_MERGED); }
    __device__ __forceinline__ bf16_t* H() const { return (bf16_t*)(ws + WS_H); }
};

#define OPAQUE_IDS(F) int lane = (F).lane, wave = (F).wave; asm volatile("" : "+v"(lane)); asm volatile("" : "+s"(wave)); const int tid = wave * 64 + lane; (void)tid
#ifndef PROBE_DUP
#define PROBE_DUP -1
#endif
#define SW(F, id, stmt) do { unsigned long long t0_ = 0; if ((PROBE_DUP) == 100 + (id) && threadIdx.x == 0) t0_ = wall_clock64(); stmt; \
    if ((PROBE_DUP) == 100 + (id) && threadIdx.x == 0) __hip_atomic_fetch_add((unsigned long long*)((F).ws + WS_CTL + 196608) + (id), wall_clock64() - t0_, __ATOMIC_RELAXED, __HIP_MEMORY_SCOPE_AGENT); } while (0)
__device__ __forceinline__ unsigned f2bf(float f) { unsigned u = __float_as_uint(f); return (u + 0x7fffu + ((u >> 16) & 1u)) >> 16; }
__device__ __forceinline__ unsigned pk2(float lo, float hi) { return f2bf(lo) | (f2bf(hi) << 16); }
__device__ __forceinline__ void transpose_item(const float* W, int N, int k0, int n0, bf16_t* WT, int ldk, int drow0, LAS float* scr, int lane) {
    const int r8 = lane >> 3, c4 = lane & 7;
    f32x4 v[8];
#pragma unroll
    for (int i = 0; i < 8; ++i) v[i] = *(const f32x4*)(W + (size_t)(k0 + 8 * i + r8) * N + n0 + 4 * c4);
#pragma unroll
    for (int i = 0; i < 8; ++i) { LAS float* d = scr + (8 * i + r8) * 33 + 4 * c4; d[0] = v[i][0]; d[1] = v[i][1]; d[2] = v[i][2]; d[3] = v[i][3]; }
    asm volatile("s_waitcnt lgkmcnt(0)" ::: "memory");
    const int c = lane & 7;
#pragma unroll
    for (int j = 0; j < 4; ++j) { const int n = (lane >> 3) + 8 * j; const LAS float* s = scr + (8 * c) * 33 + n;
        u32x4 o; o.x = pk2(s[0 * 33], s[1 * 33]); o.y = pk2(s[2 * 33], s[3 * 33]); o.z = pk2(s[4 * 33], s[5 * 33]); o.w = pk2(s[6 * 33], s[7 * 33]);
        *(u32x4*)(WT + (size_t)(drow0 + n) * ldk + k0 + 8 * c) = o; }
    asm volatile("s_waitcnt lgkmcnt(0)" ::: "memory");
}
__device__ __forceinline__ void p0a_phase(const Frame& F) {
    OPAQUE_IDS(F);
    {
        LAS float* sl = (LAS float*)F.lds;
        LAS float* red = (LAS float*)(F.lds + 8192);
        const float* cpr = inp(I_CP); const float* csm = inp(I_CS); const float* wada = inp(I_WADA);
        for (int u = F.vcu; u < 768; u += F.G) {
            const int l = u / 192, rem = u % 192, cb = rem >> 4, ks = rem & 15;
            __syncthreads();
            for (int i = tid; i < 1280; i += NTHREADS) { const int bb = i >> 7, kk = i & 127;
                const float c = bb < NBP ? cpr[bb * D + ks * 128 + kk] : csm[(bb - NBP) * D + ks * 128 + kk];
                sl[i] = c / (1.0f + __expf(-c)); }
            __syncthreads();
            const int ct = tid & 255, kh = tid >> 8;
            const float* wp = wada + ((size_t)(l * D + ks * 128 + kh * 64)) * (6 * D) + cb * 1024 + ct * 4;
            f32x4 acc[NBB];
#pragma unroll
            for (int b = 0; b < NBB; ++b) acc[b] = (f32x4){0.f, 0.f, 0.f, 0.f};
#pragma unroll 8
            for (int kk = 0; kk < 64; ++kk) { const f32x4 w = *(const f32x4*)(wp + (size_t)kk * (6 * D));
#pragma unroll
                for (int b = 0; b < NBB; ++b) acc[b] += sl[b * 128 + kh * 64 + kk] * w; }
            if (kh == 1) {
#pragma unroll
                for (int b = 0; b < NBB; ++b) *(LAS f32x4*)(red + (ct * NBB + b) * 4) = acc[b]; }
            __syncthreads();
            if (kh == 0) {
#pragma unroll
                for (int b = 0; b < NBB; ++b) { const f32x4 o = acc[b] + *(const LAS f32x4*)(red + (ct * NBB + b) * 4);
                    *(f32x4*)(F.MODP() + ((size_t)((ks * DEPTH + l) * NBB + b)) * (6 * D) + cb * 1024 + ct * 4) = o; } }
        }
        __syncthreads();
    }
    {
        LAS float* scr = (LAS float*)(F.lds + wave * 16384);
        const int gw = F.vcu * NWAVES + wave, NGW = F.G * NWAVES;
        constexpr int C_IN = 32 * (NIN / 32), C_GATE = 32 * (NGATE / 32), C_BR = 8 * (D / 32), C_OUT = 32 * (D / 32), C_W1 = 32 * (DFF / 32), C_W2 = (DFF / 64) * (D / 32), C_PW = 2 * 4;
        constexpr int C_LAYER = C_IN + C_GATE + 4 * C_BR + C_OUT + 2 * C_W1 + C_W2 + 4 * C_PW;
        for (int it = gw; it < DEPTH * C_LAYER; it += NGW) {
            const int l = it / C_LAYER; int r = it % C_LAYER;
            if (r < C_IN) { const int nblk = NIN / 32, kb = r / nblk, nb = r % nblk; transpose_item(inp(I_WIN) + (size_t)l * D * NIN, NIN, 64 * kb, 32 * nb, (bf16_t*)(F.ws + WS_BT1 + l * BT1_L), D, 32 * nb, scr, lane); continue; } r -= C_IN;
            if (r < C_GATE) { const int nblk = NGATE / 32, kb = r / nblk, nb = r % nblk; transpose_item(inp(I_WGATE) + (size_t)l * D * NGATE, NGATE, 64 * kb, 32 * nb, (bf16_t*)(F.ws + WS_BT1 + l * BT1_L), D, NIN + 32 * nb, scr, lane); continue; } r -= C_GATE;
            if (r < 4 * C_BR) { const int g = r / C_BR, rr = r % C_BR, nblk = D / 32, kb = rr / nblk, nb = rr % nblk;
                transpose_item(inp(I_WBR) + ((size_t)(l * 4 + g)) * BRW * D, D, 64 * kb, 32 * nb, (bf16_t*)(F.ws + WS_BT2 + l * BT2_L) + (size_t)g * BRW, D, 32 * nb, scr, lane); continue; } r -= 4 * C_BR;
            if (r < C_OUT) { const int nblk = D / 32, kb = r / nblk, nb = r % nblk; transpose_item(inp(I_WOUT) + (size_t)l * D * D, D, 64 * kb, 32 * nb, (bf16_t*)(F.ws + WS_BT3 + l * BT3_L), D, 32 * nb, scr, lane); continue; } r -= C_OUT;
            if (r < 2 * C_W1) { const int which = r / C_W1, rr = r % C_W1, nblk = DFF / 32, kb = rr / nblk, nb = rr % nblk, n0 = 32 * nb;
                transpose_item((which ? inp(I_W3) : inp(I_W1)) + (size_t)l * D * DFF, DFF, 64 * kb, n0, (bf16_t*)(F.ws + WS_BT4 + l * BT4_L), D, (n0 >> 7) * 256 + which * 128 + (n0 & 127), scr, lane); continue; } r -= 2 * C_W1;
            if (r < C_W2) { const int nblk = D / 32, kb = r / nblk, nb = r % nblk; transpose_item(inp(I_W2) + (size_t)l * DFF * D, D, 64 * kb, 32 * nb, (bf16_t*)(F.ws + WS_BT5 + l * BT5_L), DFF, 32 * nb, scr, lane); continue; } r -= C_W2;
            { const int g = r / C_PW, rr = r % C_PW, kb = rr / 4, nb = rr % 4;
                transpose_item(inp(I_POOLW) + ((size_t)(l * 4 + g)) * 128 * 128, 128, 64 * kb, 32 * nb, F.POOLWT() + ((size_t)(l * 4 + g)) * 128 * 128, 128, 32 * nb, scr, lane); }
        }
        const float* xpr = inp(I_XP); const float* xsm = inp(I_XS);
        for (int row = gw; row < MREAL; row += NGW) {
            const f32x4* src = (const f32x4*)(row < MP ? xpr + (size_t)row * D : xsm + (size_t)(row - MP) * D) + lane; f32x4* dst = (f32x4*)(F.X() + (size_t)row * D) + lane;
#pragma unroll
            for (int j = 0; j < 8; ++j) dst[64 * j] = src[64 * j];
        }
    }
}
__device__ __forceinline__ void p0b_phase(const Frame& F) {
    const int n = DEPTH * NBB * 6 * D;
    const float* bada = inp(I_BADA); const float* l1g = inp(I_LN1G); const float* l2g = inp(I_LN2G);
    OPAQUE_IDS(F);
    for (int i = F.vcu * NTHREADS + tid; i < n; i += F.G * NTHREADS) {
        const int k = i & (D - 1), j = (i >> 11) % 6, bb = (i / (6 * D)) % NBB, l = i / (NBB * 6 * D), col = j * D + k;
        float s = bada[l * 6 * D + col];
#pragma unroll
        for (int ks = 0; ks < 16; ++ks) s += F.MODP()[((size_t)((ks * DEPTH + l) * NBB + bb)) * (6 * D) + col];
        if (j == 1) s = l1g[l * D + k] * (1.0f + s);
        if (j == 4) s = l2g[l * D + k] * (1.0f + s);
        F.MOD()[i] = s;
    }
}
__device__ __forceinline__ void norm_phase(const Frame& F, const float* modl, int jS, int jSH) {
    OPAQUE_IDS(F);
    const int gw = F.vcu * NWAVES + wave, NGW = F.G * NWAVES;
    for (int pi = gw; pi < MREAL / 2; pi += NGW) {
        const int row = 2 * pi, bb = row < MP ? (row >> 12) : (NBP + ((row - MP) >> 2));
        const f32x4* xr = (const f32x4*)(F.X() + (size_t)row * D) + lane;
        const f32x4* sp = (const f32x4*)(modl + (size_t)(bb * 6 + jS) * D) + lane; const f32x4* hp = (const f32x4*)(modl + (size_t)(bb * 6 + jSH) * D) + lane;
        f32x4 v0[8], v1[8], sv[8], hv[8];
#pragma unroll
        for (int j = 0; j < 8; ++j) { v0[j] = xr[64 * j]; v1[j] = xr[512 + 64 * j]; }
#pragma unroll
        for (int j = 0; j < 8; ++j) { sv[j] = sp[64 * j]; hv[j] = hp[64 * j]; }
        float s0 = 0.f, s1 = 0.f;
#pragma unroll
        for (int j = 0; j < 8; ++j) { s0 += (v0[j].x * v0[j].x + v0[j].y * v0[j].y) + (v0[j].z * v0[j].z + v0[j].w * v0[j].w); s1 += (v1[j].x * v1[j].x + v1[j].y * v1[j].y) + (v1[j].z * v1[j].z + v1[j].w * v1[j].w); }
        const float r0 = 1.0f / sqrtf(wave_sum(s0) * (1.0f / D) + RMS_EPS), r1 = 1.0f / sqrtf(wave_sum(s1) * (1.0f / D) + RMS_EPS);
        u32x2* o = (u32x2*)(F.HN() + (size_t)row * D) + lane;
#pragma unroll
        for (int j = 0; j < 8; ++j) { const f32x4 y0 = v0[j] * r0 * sv[j] + hv[j], y1 = v1[j] * r1 * sv[j] + hv[j];
            u32x2 w0, w1; w0.x = cvt_pk_bf16(y0.x, y0.y); w0.y = cvt_pk_bf16(y0.z, y0.w); w1.x = cvt_pk_bf16(y1.x, y1.y); w1.y = cvt_pk_bf16(y1.z, y1.w);
            o[64 * j] = w0; o[512 + 64 * j] = w1; }
    }
}
__device__ __forceinline__ void final_norm_phase(const Frame& F) {
    OPAQUE_IDS(F);
    const int gw = F.vcu * NWAVES + wave, NGW = F.G * NWAVES;
    const f32x4* gp = (const f32x4*)inp(I_FING) + lane;
    for (int pi = gw; pi < MREAL / 2; pi += NGW) {
        const int row = 2 * pi;
        const f32x4* xr = (const f32x4*)(F.X() + (size_t)row * D) + lane;
        f32x4 v0[8], v1[8], gv[8];
#pragma unroll
        for (int j = 0; j < 8; ++j) { v0[j] = xr[64 * j]; v1[j] = xr[512 + 64 * j]; }
#pragma unroll
        for (int j = 0; j < 8; ++j) gv[j] = gp[64 * j];
        float s0 = 0.f, s1 = 0.f;
#pragma unroll
        for (int j = 0; j < 8; ++j) { s0 += (v0[j].x * v0[j].x + v0[j].y * v0[j].y) + (v0[j].z * v0[j].z + v0[j].w * v0[j].w); s1 += (v1[j].x * v1[j].x + v1[j].y * v1[j].y) + (v1[j].z * v1[j].z + v1[j].w * v1[j].w); }
        const float r0 = 1.0f / sqrtf(wave_sum(s0) * (1.0f / D) + RMS_EPS), r1 = 1.0f / sqrtf(wave_sum(s1) * (1.0f / D) + RMS_EPS);
        f32x4* o = (f32x4*)(F.out + OUT_Y + (size_t)row * D) + lane;
#pragma unroll
        for (int j = 0; j < 8; ++j) { o[64 * j] = v0[j] * r0 * gv[j]; o[512 + 64 * j] = v1[j] * r1 * gv[j]; }
    }
}

constexpr int TP = 272;
constexpr int L_KBUF = 0, L_VRAW = 128 * TP, L_VT = 2 * 128 * TP, L_BT = 3 * 128 * TP;
template <bool PERMK> __device__ __forceinline__ void lds_transpose(LAS unsigned char* raw, LAS unsigned char* vt, int tid) {
#pragma unroll
    for (int i = 0; i < 4; ++i) { const int task = tid + NTHREADS * i, c = task & 127, sq = task >> 7, s = sq >> 2, q = sq & 3;
        unsigned short e[8];
#pragma unroll
        for (int jj = 0; jj < 8; ++jj) { const int row = PERMK ? (32 * s + 16 * (jj >> 2) + 4 * q + (jj & 3)) : (32 * s + 8 * q + jj); e[jj] = *(const LAS unsigned short*)(raw + row * TP + c * 2); }
        u32x4 w; w.x = e[0] | ((unsigned)e[1] << 16); w.y = e[2] | ((unsigned)e[3] << 16); w.z = e[4] | ((unsigned)e[5] << 16); w.w = e[6] | ((unsigned)e[7] << 16);
        *(LAS u32x4*)(vt + c * TP + (32 * s + 8 * q) * 2) = w; }
}
__device__ __forceinline__ void attn_prompt_unit(const Frame& F, int idx) {
    OPAQUE_IDS(F); const int fr = lane & 15, fq = lane >> 4;
    const int gi = idx >> 8, rem = idx & 255, h = rem & 3, blk = rem >> 2, b = blk >> 5, rb = blk & 31;
    const int dsh = 2 * gi, dm = (1 << dsh) - 1, r = rb & dm, n = rb >> dsh;
    const bf16_t* Pb = F.P() + (size_t)(b * SEQ) * NIN;
    const int qcol = 1024 + gi * 1536 + h * 128, kcol = qcol + 512, vcol = qcol + 1024;
    LAS unsigned char* kbuf = F.lds + L_KBUF; LAS unsigned char* vraw = F.lds + L_VRAW; LAS unsigned char* vt = F.lds + L_VT; LAS float* bt = (LAS float*)(F.lds + L_BT);
    __syncthreads();
    if (tid < 129) bt[tid] = inp(I_RELB)[(int)BKT[gi][tid] * 12 + gi * 4 + h];
    const int iq = 16 * wave + fr;
    const size_t qpos = ((size_t)(128 * n + iq) << dsh) + r;
    bf16x8 qf[4];
#pragma unroll
    for (int s = 0; s < 4; ++s) qf[s] = *(const bf16x8*)(Pb + qpos * NIN + qcol + 32 * s + 8 * fq);
    f32x4 S[9];
#pragma unroll
    for (int t = 0; t < 9; ++t) S[t] = (f32x4){0.f, 0.f, 0.f, 0.f};
    const int hf0 = (n == 0) ? 1 : 0;
    u32x4 ra[4];
#define AT_LOAD(col, hf) do { _Pragma("unroll") for (int i = 0; i < 4; ++i) { const int c = tid + NTHREADS * i, row = c >> 4, ch = c & 15; const size_t pk = ((size_t)(128 * (n - 1 + (hf)) + row) << dsh) + r; \
        ra[i] = *(const u32x4*)(Pb + pk * NIN + (col) + ch * 8); } } while (0)
#define AT_STORE(buf) do { _Pragma("unroll") for (int i = 0; i < 4; ++i) { const int c = tid + NTHREADS * i, row = c >> 4, ch = c & 15; *(LAS u32x4*)((buf) + row * TP + ch * 16) = ra[i]; } } while (0)
#define AT_QK(hf) do { _Pragma("unroll") for (int tl = 0; tl < 9; ++tl) { const int T_ = wave + tl; if ((T_ >> 3) == (hf)) { _Pragma("unroll") for (int s = 0; s < 4; ++s) { \
        const bf16x8 kf = *(const LAS bf16x8*)(kbuf + (16 * (T_ & 7) + fr) * TP + 64 * s + 16 * fq); S[tl] = __builtin_amdgcn_mfma_f32_16x16x32_bf16(kf, qf[s], S[tl], 0, 0, 0); } } } } while (0)
    if (hf0 == 0) {
        AT_LOAD(kcol, 0); AT_STORE(kbuf); __syncthreads();
        AT_LOAD(kcol, 1); AT_QK(0); __syncthreads();
        AT_STORE(kbuf); __syncthreads();
        AT_LOAD(vcol, 0); AT_QK(1);
    } else {
        AT_LOAD(kcol, 1); AT_STORE(kbuf); __syncthreads();
        AT_LOAD(vcol, 1); AT_QK(1);
    }
    const int db = fr - 4 * fq;
    float mx = -3.0e38f;
#pragma unroll
    for (int tl = 0; tl < 9; ++tl) {
        if (((wave + tl) >> 3) >= hf0) {
#pragma unroll
            for (int j = 0; j < 4; ++j) { const int diff = 128 - 16 * tl - j + db;
                const bool valid = (tl == 0) ? (diff <= 128) : ((tl == 8) ? (diff >= 0) : true);
                const int di = (tl == 0) ? (diff < 128 ? diff : 128) : ((tl == 8) ? (diff > 0 ? diff : 0) : diff);
                const float lg = valid ? S[tl][j] * ATT_SCALE + bt[di] : -1.0e30f; S[tl][j] = lg; mx = fmaxf(mx, lg); }
        } else { S[tl] = (f32x4){-1.0e30f, -1.0e30f, -1.0e30f, -1.0e30f}; }
    }
    mx = fmaxf(mx, __shfl_xor(mx, 16)); mx = fmaxf(mx, __shfl_xor(mx, 32));
    float sum = 0.f;
#pragma unroll
    for (int tl = 0; tl < 9; ++tl)
#pragma unroll
        for (int j = 0; j < 4; ++j) { const float p = __expf(S[tl][j] - mx); S[tl][j] = p; sum += p; }
    sum += __shfl_xor(sum, 16); sum += __shfl_xor(sum, 32);
    const float inv = 1.0f / sum, lse = mx + __logf(sum);
    bf16x8 pf[5];
    { const f32x4 z4 = (f32x4){0.f, 0.f, 0.f, 0.f};
#pragma unroll
        for (int kl = 0; kl < 5; ++kl) { f32x4 a, c;
            if (wave & 1) { a = (kl == 0) ? z4 : S[kl == 0 ? 0 : 2 * kl - 1] * inv; c = S[2 * kl] * inv; }
            else { a = S[2 * kl] * inv; c = (kl == 4) ? z4 : S[kl == 4 ? 8 : 2 * kl + 1] * inv; }
            u32x4 w; w.x = cvt_pk_bf16(a[0], a[1]); w.y = cvt_pk_bf16(a[2], a[3]); w.z = cvt_pk_bf16(c[0], c[1]); w.w = cvt_pk_bf16(c[2], c[3]); pf[kl] = __builtin_bit_cast(bf16x8, w); } }
    f32x4 O[8];
#pragma unroll
    for (int et = 0; et < 8; ++et) O[et] = (f32x4){0.f, 0.f, 0.f, 0.f};
#define AT_PV(hf) do { _Pragma("unroll") for (int kl = 0; kl < 5; ++kl) { const int ks_ = (wave >> 1) + kl; if ((ks_ >> 2) == (hf)) { _Pragma("unroll") for (int et = 0; et < 8; ++et) { \
        const bf16x8 vf = *(const LAS bf16x8*)(vt + (16 * et + fr) * TP + 64 * (ks_ & 3) + 16 * fq); O[et] = __builtin_amdgcn_mfma_f32_16x16x32_bf16(vf, pf[kl], O[et], 0, 0, 0); } } } } while (0)
    if (hf0 == 0) {
        AT_STORE(vraw); __syncthreads();
        AT_LOAD(vcol, 1); lds_transpose<true>(vraw, vt, tid); __syncthreads();
        AT_PV(0); AT_STORE(vraw); __syncthreads();
        lds_transpose<true>(vraw, vt, tid); __syncthreads();
        AT_PV(1);
    } else {
        AT_STORE(vraw); __syncthreads();
        lds_transpose<true>(vraw, vt, tid); __syncthreads();
        AT_PV(1);
    }
#undef AT_LOAD
#undef AT_STORE
#undef AT_QK
#undef AT_PV
    const size_t orow = (size_t)gi * MP + (size_t)b * SEQ + qpos;
    bf16_t* op = F.OG() + orow * BRW + h * 128 + 4 * fq;
#pragma unroll
    for (int et = 0; et < 8; ++et) { u32x2 w; w.x = cvt_pk_bf16(O[et][0], O[et][1]); w.y = cvt_pk_bf16(O[et][2], O[et][3]); *(u32x2*)(op + 16 * et) = w; }
    if (fq == 0) F.LSE()[orow * 4 + h] = lse;
}
__device__ __forceinline__ void gmlp_prompt_unit(const Frame& F, int l, int idx) {
    OPAQUE_IDS(F); const int fr = lane & 15, fq = lane >> 4;
    const int g = idx & 3, chunk = idx >> 2; const size_t row0 = (size_t)chunk * 128;
    LAS unsigned char* vraw = F.lds + L_VRAW; LAS unsigned char* vt = F.lds + L_VT;
    __syncthreads();
    {
        const int myg = lane >> 4, cl = (lane & 15) * 8; const float* alng = inp(I_ALNG); const float* alnb = inp(I_ALNB);
        float lg[8], lb[8];
#pragma unroll
        for (int i = 0; i < 8; ++i) { lg[i] = alng[l * BRW + myg * 128 + cl + i]; lb[i] = alnb[l * BRW + myg * 128 + cl + i]; }
#pragma unroll
        for (int rr = 0; rr < 16; ++rr) { const int j = 16 * wave + rr;
            const u32x4 raw = *(const u32x4*)(F.P() + (row0 + j) * NIN + 512 + lane * 8);
            float x[8]; unpack8(raw, x);
            float s = 0.f;
#pragma unroll
            for (int i = 0; i < 8; ++i) s += x[i];
            const float mean = wave_sum(s) * (1.0f / BRW); float q = 0.f;
#pragma unroll
            for (int i = 0; i < 8; ++i) { x[i] -= mean; q += x[i] * x[i]; }
            const float rstd = 1.0f / sqrtf(wave_sum(q) * (1.0f / BRW) + LN_EPS);
            if (myg == g) { float y[8];
#pragma unroll
                for (int i = 0; i < 8; ++i) y[i] = x[i] * rstd * lg[i] + lb[i];
                *(LAS u32x4*)(vraw + j * TP + (lane & 15) * 16) = pack8(y); }
        }
    }
    __syncthreads();
    lds_transpose<false>(vraw, vt, tid);
    __syncthreads();
    const int i_row = 16 * wave + fr; const float* aws = inp(I_AWS);
    f32x4 acc[8];
#pragma unroll
    for (int ct = 0; ct < 8; ++ct) acc[ct] = (f32x4){0.f, 0.f, 0.f, 0.f};
#pragma unroll
    for (int s = 0; s < 4; ++s) {
        if (32 * s <= 16 * wave + 15) {
            const float* wsp = aws + ((size_t)((l * 4 + g) * 128 + i_row)) * 128 + 32 * s + 8 * fq;
            const f32x4 w0 = *(const f32x4*)wsp, w1 = *(const f32x4*)(wsp + 4);
            float wv[8] = {w0[0], w0[1], w0[2], w0[3], w1[0], w1[1], w1[2], w1[3]};
#pragma unroll
            for (int jj = 0; jj < 8; ++jj) wv[jj] = (32 * s + 8 * fq + jj <= i_row) ? wv[jj] : 0.f;
            const bf16x8 wf = __builtin_bit_cast(bf16x8, pack8(wv));
#pragma unroll
            for (int ct = 0; ct < 8; ++ct) { const bf16x8 vf = *(const LAS bf16x8*)(vt + (16 * ct + fr) * TP + 64 * s + 16 * fq);
                acc[ct] = __builtin_amdgcn_mfma_f32_16x16x32_bf16(vf, wf, acc[ct], 0, 0, 0); }
        }
    }
    const float bsv = inp(I_ABS)[(l * 4 + g) * 128 + i_row];
#pragma unroll
    for (int ct = 0; ct < 8; ++ct) { const int c0 = g * 128 + 16 * ct + 4 * fq;
        const u32x2 uw = *(const u32x2*)(F.P() + (row0 + i_row) * NIN + c0);
        const float y0 = bflo(uw.x) * (acc[ct][0] + bsv), y1 = bfhi(uw.x) * (acc[ct][1] + bsv), y2 = bflo(uw.y) * (acc[ct][2] + bsv), y3 = bfhi(uw.y) * (acc[ct][3] + bsv);
        u32x2 w; w.x = cvt_pk_bf16(y0, y1); w.y = cvt_pk_bf16(y2, y3); *(u32x2*)(F.YS() + (row0 + i_row) * D + c0) = w; }
}
template <int GI> __device__ __forceinline__ void pool_prompt_unit_t(const Frame& F, int l, int idx) {
    OPAQUE_IDS(F); const int fr = lane & 15, fq = lane >> 4;
    constexpr int gi = GI, win = 2 << GI; const int tile = idx >> 2;
    const int t = ((tile & 31) << 7) + 16 * wave + fr;
    const size_t row = (size_t)tile * 128 + 16 * wave + fr;
    const float icnt = 1.0f / (float)((t + 1) < win ? (t + 1) : win);
    f32x4 acc[8];
#pragma unroll
    for (int dt = 0; dt < 8; ++dt) acc[dt] = (f32x4){0.f, 0.f, 0.f, 0.f};
    const bf16_t* pw = F.POOLWT() + ((size_t)(l * 4 + gi)) * 128 * 128; const float* poolb = inp(I_POOLB); const float* pools = inp(I_POOLS);
#pragma unroll
    for (int s = 0; s < 4; ++s) {
        const bf16_t* pc = F.P() + row * NIN + 5632 + gi * 128 + 32 * s + 8 * fq;
        float sum[8], cur[8];
        unpack8(*(const u32x4*)pc, cur);
#pragma unroll
        for (int i = 0; i < 8; ++i) sum[i] = cur[i];
        u32x4 wr_[win - 1];
#pragma unroll
        for (int k = 1; k < win; ++k) wr_[k - 1] = *(const u32x4*)(pc - (size_t)((t - k >= 0) ? k : 0) * NIN);
#pragma unroll
        for (int k = 1; k < win; ++k) { float v[8]; unpack8(wr_[k - 1], v); const float ok = (t - k >= 0) ? 1.0f : 0.0f;
#pragma unroll
            for (int i = 0; i < 8; ++i) sum[i] += ok * v[i]; }
        float pl[8];
#pragma unroll
        for (int i = 0; i < 8; ++i) pl[i] = sum[i] * icnt - cur[i];
        const bf16x8 bfrag = __builtin_bit_cast(bf16x8, pack8(pl));
#pragma unroll
        for (int dt = 0; dt < 8; ++dt) { const bf16x8 af = *(const bf16x8*)(pw + (size_t)(16 * dt + fr) * 128 + 32 * s + 8 * fq);
            acc[dt] = __builtin_amdgcn_mfma_f32_16x16x32_bf16(af, bfrag, acc[dt], 0, 0, 0); }
        __builtin_amdgcn_sched_barrier(0);
    }
#pragma unroll
    for (int dt = 0; dt < 8; ++dt) { const int ch = gi * 128 + 16 * dt + 4 * fq;
        const f32x4 pb = *(const f32x4*)(poolb + l * BRW + ch), ps = *(const f32x4*)(pools + l * BRW + ch);
        const f32x4 y = (acc[dt] + pb) * ps;
        u32x2 w; w.x = cvt_pk_bf16(y[0], y[1]); w.y = cvt_pk_bf16(y[2], y[3]); *(u32x2*)(F.YS() + row * D + 1024 + ch) = w; }
}
__device__ __forceinline__ void pool_prompt_unit(const Frame& F, int l, int idx) {
    switch (idx & 3) { case 0: pool_prompt_unit_t<0>(F, l, idx); break; case 1: pool_prompt_unit_t<1>(F, l, idx); break; case 2: pool_prompt_unit_t<2>(F, l, idx); break; default: pool_prompt_unit_t<3>(F, l, idx); break; }
}
__device__ __forceinline__ void conv_prompt_unit(const Frame& F, int l, int idx) {
    OPAQUE_IDS(F);
    const int b = idx >> 5, t0 = ((idx & 31) << 7) + 16 * wave;
    const size_t rowb = (size_t)b * SEQ;
    float w0[8], w1[8], w2[8];
    { const float* cw = inp(I_CONVW) + ((size_t)l * BRW + 8 * lane) * 3; float t[24];
#pragma unroll
        for (int i = 0; i < 6; ++i) { const f32x4 v = *(const f32x4*)(cw + 4 * i); t[4 * i] = v[0]; t[4 * i + 1] = v[1]; t[4 * i + 2] = v[2]; t[4 * i + 3] = v[3]; }
#pragma unroll
        for (int i = 0; i < 8; ++i) { w0[i] = t[3 * i]; w1[i] = t[3 * i + 1]; w2[i] = t[3 * i + 2]; } }
    float z2[8], z1[8];
#pragma unroll
    for (int i = 0; i < 8; ++i) { z2[i] = 0.f; z1[i] = 0.f; }
    for (int cb = 0; cb < 3; ++cb) {
        u32x4 rc[6], rh[6], rb[6];
#pragma unroll
        for (int j = 0; j < 6; ++j) { const int tt = t0 - 2 + 6 * cb + j; const bf16_t* pr = F.P() + (rowb + (tt < 0 ? 0 : tt)) * NIN + 6144 + 8 * lane;
            rc[j] = *(const u32x4*)(pr + 512); rh[j] = *(const u32x4*)(pr + 1024); rb[j] = *(const u32x4*)pr; }
#pragma unroll
        for (int j = 0; j < 6; ++j) { const int tt = t0 - 2 + 6 * cb + j;
            float cg[8], hs[8], z[8]; unpack8(rc[j], cg); unpack8(rh[j], hs); const float ok = tt >= 0 ? 1.0f : 0.0f;
#pragma unroll
            for (int i = 0; i < 8; ++i) z[i] = ok * cg[i] * hs[i];
            if (tt >= t0) {
                float bg[8], y[8]; unpack8(rb[j], bg);
#pragma unroll
                for (int i = 0; i < 8; ++i) y[i] = bg[i] * (z2[i] * w0[i] + z1[i] * w1[i] + z[i] * w2[i]);
                *(u32x4*)(F.YS() + (rowb + tt) * D + 1536 + 8 * lane) = pack8(y);
                if (tt >= SEQ - 2) { float* o = F.out + OUT_CONVP + ((size_t)((l * NBP + b) * 2 + (tt - (SEQ - 2)))) * BRW + 8 * lane;
                    *(f32x4*)o = (f32x4){z[0], z[1], z[2], z[3]}; *(f32x4*)(o + 4) = (f32x4){z[4], z[5], z[6], z[7]}; }
            }
#pragma unroll
            for (int i = 0; i < 8; ++i) { z2[i] = z1[i]; z1[i] = z[i]; }
        }
    }
}
__device__ __forceinline__ void attn_sample_unit(const Frame& F, int l, int idx) {
    OPAQUE_IDS(F);
    const int h = idx & 3, t = (idx >> 2) & 3, b = idx >> 4;
    LAS float* qs = (LAS float*)F.lds;
    LAS float* ps = qs + 768;
    LAS float* os = ps + 408;
    LAS float* ms = os + 768;
    const size_t prow = (size_t)(MP + b * TS + t);
    __syncthreads();
    if (wave < 6) {
        const int gi = wave >> 1, half = wave & 1, dsh = 2 * gi, wb = 128 << dsh;
        const int qcol = 1024 + gi * 1536 + h * 128, kcol = qcol + 512, vcol = qcol + 1024;
        const bf16_t* Pp = F.P();
        { const unsigned qw = *(const unsigned*)(Pp + prow * NIN + qcol + 2 * lane); qs[wave * 128 + 2 * lane] = bflo(qw); qs[wave * 128 + 2 * lane + 1] = bfhi(qw); }
        if (half == 0) {
            float* ob = F.out + (gi == 0 ? OUT_B1S : (gi == 1 ? OUT_B2S : OUT_B3S)) + ((size_t)((l * NBS + b) * TS + t)) * 1024 + h * 128 + 2 * lane;
            const unsigned kw = *(const unsigned*)(Pp + prow * NIN + kcol + 2 * lane), vw = *(const unsigned*)(Pp + prow * NIN + vcol + 2 * lane);
            *(f32x2*)ob = (f32x2){bflo(kw), bfhi(kw)}; *(f32x2*)(ob + 512) = (f32x2){bflo(vw), bfhi(vw)}; }
        asm volatile("s_waitcnt lgkmcnt(0)" ::: "memory");
        const float* relb = inp(I_RELB);
        const float* cache = inp(I_CB1 + gi) + ((size_t)(l * NBS + b) * wb) * 1024;
        const int st0 = half * 65, nkeys = 65 - half;
        float lg[2]; float mx = -3.0e38f;
#pragma unroll
        for (int k2 = 0; k2 < 2; ++k2) { const int j = lane + 64 * k2, st = st0 + j; lg[k2] = -3.0e38f;
            if (j < nkeys) { const int kidx = wb + t - (st << dsh); float dot = 0.f;
                if (kidx < wb) { const float* kp = cache + (size_t)kidx * 1024 + h * 128;
#pragma unroll 8
                    for (int e = 0; e < 128; e += 4) { const f32x4 kv = *(const f32x4*)(kp + e); const f32x4 qv = *(const LAS f32x4*)(qs + wave * 128 + e); dot += (kv[0] * qv[0] + kv[1] * qv[1]) + (kv[2] * qv[2] + kv[3] * qv[3]); } }
                else { const bf16_t* kp = Pp + (size_t)(MP + b * TS + (kidx - wb)) * NIN + kcol;
#pragma unroll 4
                    for (int e = 0; e < 128; e += 8) { float kv[8]; unpack8(*(const u32x4*)(kp + e), kv);
#pragma unroll
                        for (int i = 0; i < 8; ++i) dot += kv[i] * qs[wave * 128 + e + i]; } }
                lg[k2] = dot * ATT_SCALE + relb[(int)BKT[gi][st] * 12 + gi * 4 + h]; mx = fmaxf(mx, lg[k2]); } }
        mx = wave_max(mx);
        float sum = 0.f;
#pragma unroll
        for (int k2 = 0; k2 < 2; ++k2) { const int j = lane + 64 * k2; if (j < nkeys) { const float p = __expf(lg[k2] - mx); sum += p; ps[wave * 68 + j] = p; } }
        sum = wave_sum(sum);
        asm volatile("s_waitcnt lgkmcnt(0)" ::: "memory");
        const int kq = lane >> 4, ec = lane & 15;
        float o[8];
#pragma unroll
        for (int i = 0; i < 8; ++i) o[i] = 0.f;
#pragma unroll 4
        for (int j = kq; j < nkeys; j += 4) { const int st = st0 + j, kidx = wb + t - (st << dsh); const float p = ps[wave * 68 + j];
            if (kidx < wb) { const float* vp = cache + (size_t)kidx * 1024 + 512 + h * 128 + 8 * ec; const f32x4 v0 = *(const f32x4*)vp, v1 = *(const f32x4*)(vp + 4);
                o[0] += p * v0[0]; o[1] += p * v0[1]; o[2] += p * v0[2]; o[3] += p * v0[3]; o[4] += p * v1[0]; o[5] += p * v1[1]; o[6] += p * v1[2]; o[7] += p * v1[3]; }
            else { float v[8]; unpack8(*(const u32x4*)(Pp + (size_t)(MP + b * TS + (kidx - wb)) * NIN + vcol + 8 * ec), v);
#pragma unroll
                for (int i = 0; i < 8; ++i) o[i] += p * v[i]; } }
#pragma unroll
        for (int i = 0; i < 8; ++i) { o[i] += __shfl_xor(o[i], 16); o[i] += __shfl_xor(o[i], 32); }
        if (kq == 0) {
#pragma unroll
            for (int i = 0; i < 8; ++i) os[wave * 128 + 8 * ec + i] = o[i]; }
        if (lane == 0) { ms[wave * 2] = mx; ms[wave * 2 + 1] = sum; }
    }
    __syncthreads();
    if (tid < 128) {
        float O[3], L[3];
#pragma unroll
        for (int g = 0; g < 3; ++g) { const float m0 = ms[4 * g], s0 = ms[4 * g + 1], m1 = ms[4 * g + 2], s1 = ms[4 * g + 3], mg = fmaxf(m0, m1), a0 = __expf(m0 - mg), a1 = __expf(m1 - mg), S = s0 * a0 + s1 * a1;
            O[g] = (os[(2 * g) * 128 + tid] * a0 + os[(2 * g + 1) * 128 + tid] * a1) / S; L[g] = mg + __logf(S); }
        const float m = fmaxf(L[0], fmaxf(L[1], L[2])), e0 = __expf(L[0] - m), e1 = __expf(L[1] - m), e2 = __expf(L[2] - m);
        const float y = (e0 * O[0] + e1 * O[1] + e2 * O[2]) / (e0 + e1 + e2);
        F.YS()[prow * D + 512 + h * 128 + tid] = (bf16_t)f2bf(y); }
}
__device__ __forceinline__ void misc_sample_unit(const Frame& F, int l, int b) {
    OPAQUE_IDS(F);
    LAS float* red = (LAS float*)F.lds;
    LAS float* pl = red + 64;
    const size_t prow = (size_t)(MP + b * TS);
    __syncthreads();
    float vx[4], s4[4];
#pragma unroll
    for (int j = 0; j < 4; ++j) { vx[j] = bf1(F.P()[(prow + j) * NIN + 512 + tid]); s4[j] = wave_sum(vx[j]); }
    if (lane == 0) {
#pragma unroll
        for (int j = 0; j < 4; ++j) red[wave * 4 + j] = s4[j]; }
    __syncthreads();
    float mean[4];
#pragma unroll
    for (int j = 0; j < 4; ++j) { float s = 0.f;
#pragma unroll
        for (int w = 0; w < 8; ++w) s += red[w * 4 + j];
        mean[j] = s * (1.0f / BRW); vx[j] -= mean[j]; }
    __syncthreads();
#pragma unroll
    for (int j = 0; j < 4; ++j) s4[j] = wave_sum(vx[j] * vx[j]);
    if (lane == 0) {
#pragma unroll
        for (int j = 0; j < 4; ++j) red[wave * 4 + j] = s4[j]; }
    __syncthreads();
    const float lng = inp(I_ALNG)[l * BRW + tid], lnb = inp(I_ALNB)[l * BRW + tid];
    float v[4];
#pragma unroll
    for (int j = 0; j < 4; ++j) { float s = 0.f;
#pragma unroll
        for (int w = 0; w < 8; ++w) s += red[w * 4 + j];
        v[j] = vx[j] / sqrtf(s * (1.0f / BRW) + LN_EPS) * lng + lnb;
        F.out[OUT_CHUNKV + ((size_t)((l * NBS + b) * TS + j)) * BRW + tid] = v[j]; }
    { const int g = tid >> 7; const float* wsb = inp(I_AWS) + ((size_t)(l * 4 + g)) * 128 * 128; const float* absp = inp(I_ABS);
#pragma unroll
        for (int i = 0; i < 4; ++i) { float mix = absp[(l * 4 + g) * 128 + i];
#pragma unroll
            for (int j = 0; j < 4; ++j) if (j <= i) mix += wsb[i * 128 + j] * v[j];
            const float u = bf1(F.P()[(prow + i) * NIN + tid]);
            F.YS()[(prow + i) * D + tid] = (bf16_t)f2bf(u * mix); } }
    { const int gi = tid >> 7, win = 2 << gi; float full[19]; const float* cpool = inp(I_CPOOL);
#pragma unroll
        for (int k = 0; k < 15; ++k) full[k] = cpool[((size_t)((l * NBS + b) * 15 + k)) * BRW + tid];
#pragma unroll
        for (int j = 0; j < 4; ++j) { full[15 + j] = bf1(F.P()[(prow + j) * NIN + 5632 + tid]); F.out[OUT_POOLS + ((size_t)((l * NBS + b) * TS + j)) * BRW + tid] = full[15 + j]; }
#pragma unroll
        for (int j = 0; j < 4; ++j) { float s = 0.f;
#pragma unroll
            for (int k = 0; k < 16; ++k) if (k < win) s += full[15 + j - k];
            pl[j * BRW + tid] = s / (float)win - full[15 + j]; } }
    __syncthreads();
    { const int g = tid >> 7, d = tid & 127; const float* pw = inp(I_POOLW) + ((size_t)(l * 4 + g)) * 128 * 128 + d;
        float y[4] = {0.f, 0.f, 0.f, 0.f};
#pragma unroll 8
        for (int c = 0; c < 128; ++c) { const float w = pw[c * 128];
#pragma unroll
            for (int j = 0; j < 4; ++j) y[j] += pl[j * BRW + g * 128 + c] * w; }
        const float pb = inp(I_POOLB)[l * BRW + tid], psc = inp(I_POOLS)[l * BRW + tid];
#pragma unroll
        for (int j = 0; j < 4; ++j) F.YS()[(prow + j) * D + 1024 + tid] = (bf16_t)f2bf((y[j] + pb) * psc); }
    { const float* cvw = inp(I_CONVW) + ((size_t)l * BRW + tid) * 3; const float* ccv = inp(I_CCONV) + ((size_t)(l * NBS + b) * 2) * BRW + tid; const float w0 = cvw[0], w1 = cvw[1], w2 = cvw[2];
        float z2 = ccv[0], z1 = ccv[BRW];
#pragma unroll
        for (int j = 0; j < 4; ++j) { const bf16_t* pr = F.P() + (prow + j) * NIN + 6144 + tid; const float z = bf1(pr[512]) * bf1(pr[1024]);
            const float y = bf1(pr[0]) * (z2 * w0 + z1 * w1 + z * w2);
            F.YS()[(prow + j) * D + 1536 + tid] = (bf16_t)f2bf(y); F.out[OUT_CONVS + ((size_t)((l * NBS + b) * TS + j)) * BRW + tid] = z; z2 = z1; z1 = z; } }
}
constexpr int MX_SATT = 0, MX_ATT = 128, MX_GMLP = 896, MX_POOL = 1152, MX_CONV = 1408, MX_SMISC = 1472, MX_END = 1480;
constexpr int CW_QUEUE = 8192;
#ifndef UNIT_MASK
#define UNIT_MASK 0xFF
#endif
#define UON(k) (((UNIT_MASK) >> (k)) & 1)
__device__ __forceinline__ void mixer_phase(const Frame& F, int l) {
    unsigned* head = (unsigned*)(F.ws + WS_CTL) + CW_QUEUE + 64 * l;
    volatile LAS unsigned* qw = (volatile LAS unsigned*)(F.lds + MISC_OFF) + 16;
    if (F.tid == 0) qw[0] = __hip_atomic_fetch_add(head, 1u, __ATOMIC_RELAXED, __HIP_MEMORY_SCOPE_AGENT);
    __syncthreads();
    int u = (int)qw[0];
    while (u < MX_END) {
        if (u < MX_ATT) { if (UON(0)) SW(F, 0, attn_sample_unit(F, l, u)); }
        else if (u < MX_GMLP) { if (UON(2)) SW(F, 1, attn_prompt_unit(F, u - MX_ATT)); }
        else if (u < MX_POOL) { if (UON(3)) SW(F, 2, gmlp_prompt_unit(F, l, u - MX_GMLP)); }
        else if (u < MX_CONV) { if (UON(4)) SW(F, 3, pool_prompt_unit(F, l, u - MX_POOL)); }
        else if (u < MX_SMISC) { if (UON(5)) SW(F, 4, conv_prompt_unit(F, l, u - MX_CONV)); }
        else { if (UON(1)) SW(F, 5, misc_sample_unit(F, l, u - MX_SMISC)); }
        if (F.tid == 0) qw[0] = __hip_atomic_fetch_add(head, 1u, __ATOMIC_RELAXED, __HIP_MEMORY_SCOPE_AGENT);
        __syncthreads();
        u = (int)qw[0];
        __syncthreads();
    }
}
__device__ __forceinline__ void combine_phase(const Frame& F, int l) {
    OPAQUE_IDS(F);
    const int gw = F.vcu * NWAVES + wave, NGW = F.G * NWAVES;
    for (int row = gw; row < MP; row += NGW) {
        const int h = lane >> 4;
        const float l0 = F.LSE()[((size_t)0 * MP + row) * 4 + h], l1 = F.LSE()[((size_t)1 * MP + row) * 4 + h], l2 = F.LSE()[((size_t)2 * MP + row) * 4 + h];
        const float m = fmaxf(l0, fmaxf(l1, l2)), e0 = __expf(l0 - m), e1 = __expf(l1 - m), e2 = __expf(l2 - m), inv = 1.0f / (e0 + e1 + e2);
        float a[8], c[8], y[8];
        unpack8(*(const u32x4*)(F.OG() + ((size_t)0 * MP + row) * BRW + 8 * lane), a);
#pragma unroll
        for (int i = 0; i < 8; ++i) y[i] = e0 * a[i];
        unpack8(*(const u32x4*)(F.OG() + ((size_t)1 * MP + row) * BRW + 8 * lane), c);
#pragma unroll
        for (int i = 0; i < 8; ++i) y[i] += e1 * c[i];
        unpack8(*(const u32x4*)(F.OG() + ((size_t)2 * MP + row) * BRW + 8 * lane), a);
#pragma unroll
        for (int i = 0; i < 8; ++i) y[i] = (y[i] + e2 * a[i]) * inv;
        *(u32x4*)(F.YS() + (size_t)row * D + 512 + 8 * lane) = pack8(y);
    }
    constexpr int NR = NBP * (128 + 512 + 2048);
    for (int it = gw; it < NR; it += NGW) {
        int gi, rem;
        if (it < NBP * 128) { gi = 0; rem = it; } else if (it < NBP * (128 + 512)) { gi = 1; rem = it - NBP * 128; } else { gi = 2; rem = it - NBP * (128 + 512); }
        const int keep = 128 << (2 * gi), b = rem / keep, rr = rem % keep;
        const bf16_t* src = F.P() + ((size_t)b * SEQ + SEQ - keep + rr) * NIN + 1024 + gi * 1536 + 512 + 16 * lane;
        float* dst = F.out + (gi == 0 ? OUT_B1P : (gi == 1 ? OUT_B2P : OUT_B3P)) + ((size_t)((l * NBP + b) * keep + rr)) * 1024 + 16 * lane;
        float a[8], c[8]; unpack8(*(const u32x4*)src, a); unpack8(*(const u32x4*)(src + 8), c);
        *(f32x4*)dst = (f32x4){a[0], a[1], a[2], a[3]}; *(f32x4*)(dst + 4) = (f32x4){a[4], a[5], a[6], a[7]};
        *(f32x4*)(dst + 8) = (f32x4){c[0], c[1], c[2], c[3]}; *(f32x4*)(dst + 12) = (f32x4){c[4], c[5], c[6], c[7]};
    }
    for (int it = gw; it < NBP * 15; it += NGW) { const int b = it / 15, rr = it % 15;
        float a[8]; unpack8(*(const u32x4*)(F.P() + ((size_t)b * SEQ + SEQ - 15 + rr) * NIN + 5632 + 8 * lane), a);
        float* dst = F.out + OUT_POOLP + ((size_t)((l * NBP + b) * 15 + rr)) * BRW + 8 * lane;
        *(f32x4*)dst = (f32x4){a[0], a[1], a[2], a[3]}; *(f32x4*)(dst + 4) = (f32x4){a[4], a[5], a[6], a[7]}; }
}


__device__ __forceinline__ void skinny_res(const Frame& F, const bf16_t* A, const bf16_t* Bt, int ld, int K, const float* modl, int jg) {
    OPAQUE_IDS(F); const int fr = lane & 15, fq = lane >> 4;
    LAS f32x4* red = (LAS f32x4*)F.lds;
    const int kw = K / 8;
    for (int p = F.vcu; p < 2 * (D / 16); p += F.G) {
        const int n0 = 16 * (p >> 1), r0 = MP + 16 * (p & 1);
        const bf16_t* ap = A + (size_t)(r0 + fr) * ld + wave * kw + 8 * fq;
        const bf16_t* bp = Bt + (size_t)(n0 + fr) * ld + wave * kw + 8 * fq;
        f32x4 a0 = (f32x4){0.f, 0.f, 0.f, 0.f};
#pragma unroll 8
        for (int ks = 0; ks < kw / 32; ++ks) { const bf16x8 bf = *(const bf16x8*)(bp + 32 * ks), x0 = *(const bf16x8*)(ap + 32 * ks);
            a0 = __builtin_amdgcn_mfma_f32_16x16x32_bf16(bf, x0, a0, 0, 0, 0); }
        __syncthreads();
        red[wave * 64 + lane] = a0;
        __syncthreads();
        if (wave == 0) { f32x4 sm = red[lane];
#pragma unroll
            for (int w = 1; w < 8; ++w) sm += red[w * 64 + lane];
            const int row = r0 + fr, col = n0 + 4 * fq, bb = NBP + ((row - MP) >> 2);
            const f32x4 gv = *(const f32x4*)(modl + (size_t)(bb * 6 + jg) * D + col); f32x4* xp = (f32x4*)(F.X() + (size_t)row * D + col); *xp = *xp + gv * sm; }
    }
}
__device__ __forceinline__ void skinny_branch(const Frame& F, int l) {
    OPAQUE_IDS(F); const int fr = lane & 15, fq = lane >> 4;
    LAS f32x4* red = (LAS f32x4*)F.lds;
    const int g = wave >> 1, kh = wave & 1;
    const bf16_t* Bt2 = (const bf16_t*)(F.ws + WS_BT2 + l * BT2_L);
    for (int p = F.vcu; p < 2 * (D / 16); p += F.G) {
        const int n0 = 16 * (p >> 1), r0 = MP + 16 * (p & 1);
        const bf16_t* ap = F.YS() + (size_t)(r0 + fr) * D + g * BRW + kh * 256 + 8 * fq;
        const bf16_t* bp = Bt2 + (size_t)(n0 + fr) * D + g * BRW + kh * 256 + 8 * fq;
        f32x4 a0 = (f32x4){0.f, 0.f, 0.f, 0.f};
#pragma unroll
        for (int ks = 0; ks < 8; ++ks) { const bf16x8 bf = *(const bf16x8*)(bp + 32 * ks), x0 = *(const bf16x8*)(ap + 32 * ks);
            a0 = __builtin_amdgcn_mfma_f32_16x16x32_bf16(bf, x0, a0, 0, 0, 0); }
        const u32x2 g0 = *(const u32x2*)(F.GATES() + (size_t)(r0 + fr) * NGATE + (size_t)g * D + n0 + 4 * fq);
        a0 *= (f32x4){bflo(g0.x), bfhi(g0.x), bflo(g0.y), bfhi(g0.y)};
        __syncthreads();
        red[wave * 64 + lane] = a0;
        __syncthreads();
        if (wave == 0) { f32x4 sm = red[lane];
#pragma unroll
            for (int w = 1; w < 8; ++w) sm += red[w * 64 + lane];
            u32x2 o; o.x = cvt_pk_bf16(sm[0], sm[1]); o.y = cvt_pk_bf16(sm[2], sm[3]);
            *(u32x2*)(F.MERGED() + (size_t)(r0 + fr) * D + n0 + 4 * fq) = o; }
    }
}

struct Args { const float* in[31]; float* out; unsigned char* ws; int ph_lo, ph_hi; };
constexpr int PH_PER_LAYER = 9, PH_FINAL = 2 + DEPTH * PH_PER_LAYER, N_PHASES = PH_FINAL + 1;

__global__ void __launch_bounds__(NTHREADS, 2) fwd_kernel(Args args) {
    extern __shared__ __attribute__((aligned(16))) unsigned char lds_raw[];
    Frame F;
    F.lds = (LAS unsigned char*)lds_raw;
    F.tid = threadIdx.x; F.lane = F.tid & 63; F.wave = __builtin_amdgcn_readfirstlane(F.tid >> 6);
    F.G = gridDim.x; { const int bx = blockIdx.x; F.vcu = (F.G % 8 == 0) ? (bx % 8) * (F.G / 8) + bx / 8 : bx; }
    F.out = args.out; F.ws = args.ws;
    unsigned char* ws = args.ws;

    volatile LAS unsigned* MISC = (volatile LAS unsigned*)(F.lds + MISC_OFF);
    for (int u = F.tid; u < (LDS_BYTES - LDSCTL_OFF) / 4; u += NTHREADS) ((LAS unsigned*)(F.lds + LDSCTL_OFF))[u] = 0u;
    __syncthreads();
    const int lo = args.ph_lo, hi = args.ph_hi;
    XcdBarrier bar; bar.bar = (unsigned*)(ws + WS_CTL) + CW_BAR; bar.x = 0; bar.st = nullptr;
    if (hi - lo > 1) bar = xcd_barrier_post((unsigned*)(ws + WS_CTL) + CW_BAR, MISC + 8);
#ifndef PHASE_MASK
#define PHASE_MASK 0xFFFF
#endif
#define ON(kind) (((PHASE_MASK) >> (kind)) & 1)
#define DUP(kind) for (int rep_ = 0; rep_ < ((PROBE_DUP) == (kind) ? 2 : 1); ++rep_)
#define IN(k) (lo <= (k) && (k) < hi)
#define SEAM(k) do { if (IN(k) && IN((k) + 1)) { \
        if ((PROBE_DUP) >= 40 && (PROBE_DUP) < 100 && threadIdx.x == 0) { unsigned long long* tw = (unsigned long long*)(ws + WS_CTL + 131072) + 2 * (k); const unsigned long long t_ = wall_clock64(); \
            __hip_atomic_fetch_max(tw, t_, __ATOMIC_RELAXED, __HIP_MEMORY_SCOPE_AGENT); __hip_atomic_fetch_add(tw + 1, t_, __ATOMIC_RELAXED, __HIP_MEMORY_SCOPE_AGENT); } \
        xcd_barrier(bar); if ((PROBE_DUP) == 20) xcd_barrier(bar); } } while (0)

    if (ON(0) && IN(0)) DUP(0) { p0a_phase(F); } SEAM(0);
    if (ON(1) && IN(1)) { p0b_phase(F); } SEAM(1);
    for (int l = 0; l < DEPTH; ++l) {
        const int pb = 2 + l * PH_PER_LAYER;
        const float* modl = F.MOD() + (size_t)l * NBB * 6 * D;
        if (ON(2) && IN(pb + 0)) DUP(2) { norm_phase(F, modl, 1, 0); } SEAM(pb + 0);
        if ((PROBE_DUP) == 30 && l == 1 && blockIdx.x == 0 && threadIdx.x == 0) { unsigned long long* st = (unsigned long long*)(ws + WS_CTL + 65536); st[0] = wall_clock64(); st[1] = clock64(); }
        if (ON(3) && IN(pb + 1)) DUP(3) {
            pg8::Gemm g{F.HN(), (const bf16_t*)(ws + WS_BT1 + l * BT1_L), D, D, D}; pg8::StaticOrder S; S.init(MPAD / 256, N1 / 256, F.G, (int)blockIdx.x, D, D);
            pg8::Epi1 E{F.P(), F.GATES(), inp(I_BGATE) + (size_t)l * NGATE};
            pg8::gemm_phase<pg8::Epi1, pg8::StaticOrder>(F.lds, g, S, E);
        }
        if ((PROBE_DUP) == 30 && l == 1 && blockIdx.x == 0 && threadIdx.x == 0) { unsigned long long* st = (unsigned long long*)(ws + WS_CTL + 65536); st[2] = wall_clock64(); st[3] = clock64(); }
        SEAM(pb + 1);
        if (ON(4) && IN(pb + 2)) DUP(4) { SW(F, 9, mixer_phase(F, l)); } SEAM(pb + 2);
        if (ON(5) && IN(pb + 3)) DUP(5) { combine_phase(F, l); } SEAM(pb + 3);
        if (ON(6) && IN(pb + 4)) DUP(6) {
            SW(F, 6, pg8::gemm_gated_phase(F.lds, F.YS(), (const bf16_t*)(ws + WS_BT2 + l * BT2_L), F.GATES(), F.MERGED(), (MP / 256) * (D / 128), F.G, F.vcu));
            SW(F, 7, skinny_branch(F, l));
        } SEAM(pb + 4);
        if (ON(7) && IN(pb + 5)) DUP(7) {
            pg8::Gemm g{F.MERGED(), (const bf16_t*)(ws + WS_BT3 + l * BT3_L), D, D, D}; pg8::StaticOrder S; S.init(MP / 256, D / 256, F.G, (int)blockIdx.x, D, D);
            pg8::EpiRes E{rep_ ? (float*)(ws + WS_H) : F.X(), modl, 2};
            pg8::gemm_phase<pg8::EpiRes, pg8::StaticOrder>(F.lds, g, S, E);
            if (!rep_) skinny_res(F, F.MERGED(), (const bf16_t*)(ws + WS_BT3 + l * BT3_L), D, D, modl, 2);
        } SEAM(pb + 5);
        if (ON(8) && IN(pb + 6)) { norm_phase(F, modl, 4, 3); } SEAM(pb + 6);
        if (ON(9) && IN(pb + 7)) DUP(9) {
            pg8::Gemm g{F.HN(), (const bf16_t*)(ws + WS_BT4 + l * BT4_L), D, D, D}; pg8::StaticOrder S; S.init(MPAD / 256, N4 / 256, F.G, (int)blockIdx.x, D, D);
            pg8::EpiSwi E{F.H()};
            pg8::gemm_phase<pg8::EpiSwi, pg8::StaticOrder>(F.lds, g, S, E);
        } SEAM(pb + 7);
        if (ON(10) && IN(pb + 8)) DUP(10) {
            pg8::Gemm g{F.H(), (const bf16_t*)(ws + WS_BT5 + l * BT5_L), DFF, DFF, DFF}; pg8::StaticOrder S; S.init(MP / 256, D / 256, F.G, (int)blockIdx.x, DFF, DFF);
            pg8::EpiRes E{rep_ ? (float*)(ws + WS_P) : F.X(), modl, 5};
            pg8::gemm_phase<pg8::EpiRes, pg8::StaticOrder>(F.lds, g, S, E);
            if (!rep_) SW(F, 8, skinny_res(F, F.H(), (const bf16_t*)(ws + WS_BT5 + l * BT5_L), DFF, DFF, modl, 5));
        } SEAM(pb + 8);
    }
    if (ON(11) && IN(PH_FINAL)) { final_norm_phase(F); }
    if ((PROBE_DUP) >= 40 && (PROBE_DUP) < 100 && blockIdx.x == 0 && threadIdx.x == 0) {
        unsigned long long idle = 0;
        for (int k = 0; k < PH_FINAL; ++k) { const int kind = k < 2 ? k : 2 + (k - 2) % PH_PER_LAYER;
            if ((PROBE_DUP) >= 60) { if ((PROBE_DUP) - 60 == kind && k > 0) { unsigned long long* tw = (unsigned long long*)(ws + WS_CTL + 131072) + 2 * k;
                    idle += __hip_atomic_load(tw, __ATOMIC_RELAXED, __HIP_MEMORY_SCOPE_AGENT) - __hip_atomic_load(tw - 2, __ATOMIC_RELAXED, __HIP_MEMORY_SCOPE_AGENT); } }
            else if ((PROBE_DUP) == 40 || (PROBE_DUP) - 41 == kind) { unsigned long long* tw = (unsigned long long*)(ws + WS_CTL + 131072) + 2 * k;
                const unsigned long long mx = __hip_atomic_load(tw, __ATOMIC_RELAXED, __HIP_MEMORY_SCOPE_AGENT), sm = __hip_atomic_load(tw + 1, __ATOMIC_RELAXED, __HIP_MEMORY_SCOPE_AGENT); idle += mx - sm / gridDim.x; } }
        const unsigned long long t0 = wall_clock64(); while (wall_clock64() - t0 < idle) __builtin_amdgcn_s_sleep(8); }
    if ((PROBE_DUP) >= 100 && blockIdx.x == 0 && threadIdx.x == 0) { const unsigned long long v = __hip_atomic_load((unsigned long long*)(ws + WS_CTL + 196608) + ((PROBE_DUP) - 100), __ATOMIC_RELAXED, __HIP_MEMORY_SCOPE_AGENT) / gridDim.x;
        const unsigned long long t0 = wall_clock64(); while (wall_clock64() - t0 < v) __builtin_amdgcn_s_sleep(8); }
    if ((PROBE_DUP) == 30 && blockIdx.x == 0 && threadIdx.x == 0) { const unsigned long long* st = (const unsigned long long*)(ws + WS_CTL + 65536);
        const unsigned long long dt = st[2] - st[0], dc = st[3] - st[1], mhz = dt ? dc * 100ull / dt : 0ull, t0 = wall_clock64();
        while (wall_clock64() - t0 < mhz * 10ull) __builtin_amdgcn_s_sleep(8); }
#undef IN
#undef SEAM
}

extern "C" void kernel_launch(void* const* d_in, const int* in_sizes, int n_in, void* d_out, int out_size, void* d_ws, size_t ws_size, hipStream_t stream) {
    static int grid = 0;
    if (grid == 0) {
        if (n_in != 31 || (size_t)out_size != OUT_END || ws_size < WS_END) { fprintf(stderr, "kernel_launch: unexpected problem (n_in %d, out %d, ws %zu)\n", n_in, out_size, ws_size); grid = -1; return; }
        int dev = 0, cus = 0, per_cu = 0;
        if (hipGetDevice(&dev) != hipSuccess || hipDeviceGetAttribute(&cus, hipDeviceAttributeMultiprocessorCount, dev) != hipSuccess) { grid = -1; return; }
        if (hipFuncSetAttribute((const void*)fwd_kernel, hipFuncAttributeMaxDynamicSharedMemorySize, LDS_BYTES) != hipSuccess) { fprintf(stderr, "kernel_launch: hipFuncSetAttribute failed\n"); grid = -1; return; }
        if (hipOccupancyMaxActiveBlocksPerMultiprocessor(&per_cu, (const void*)fwd_kernel, NTHREADS, LDS_BYTES) != hipSuccess || per_cu < 1) fprintf(stderr, "kernel_launch: occupancy query reports %d\n", per_cu);
        (void)hipGetLastError();
        grid = cus < 256 ? cus : 256;
    }
    if (grid < 0) return;
    if (hipMemsetAsync((char*)d_ws + WS_CTL, 0, CTL_ZERO_BYTES, stream) != hipSuccess) return;
    Args a{};
    for (int i = 0; i < 31; ++i) a.in[i] = (const float*)d_in[i];
    a.out = (float*)d_out; a.ws = (unsigned char*)d_ws;
#if MK_MULTI_LAUNCH
    for (int ph = 0; ph < N_PHASES; ++ph) { a.ph_lo = ph; a.ph_hi = ph + 1; hipLaunchKernelGGL(fwd_kernel, dim3(grid), dim3(NTHREADS), LDS_BYTES, stream, a); }
#else
    a.ph_lo = 0; a.ph_hi = N_PHASES; hipLaunchKernelGGL(fwd_kernel, dim3(grid), dim3(NTHREADS), LDS_BYTES, stream, a);
#endif
}
```
